# Optimizing an MI355X kernel written in HIP

```python
import math
import jax, jax.numpy as jnp
from jax import lax
import numpy as np

D_MODEL = 1024
BATCH = 8
SEQ = 4096
DEPTH = 1

D_MIX = D_MODEL
D_CONV = D_MIX // 2
D_ATTN = D_MIX - D_CONV
HEAD_DIM = 64
N_HEADS = D_ATTN // HEAD_DIM
N_CONV_GROUPS = D_CONV // HEAD_DIM
CONV_WIDTH = 31
BLOCK = 256
TOP_K = 3
Q_CHUNK = 32
ROPE_DIM = HEAD_DIM // 4
ROPE_THETA = 500000.0
EPS = 1e-6
NEG = -1e30
SPLITS = (D_CONV, D_CONV, D_CONV, D_ATTN, D_ATTN, D_ATTN, D_ATTN)
D_IN = sum(SPLITS)

kernel_name = "hybrid_conformer_conv_moba_parallel_heads"


def rmsnorm(x, g):
    xf = x.astype(jnp.float32)
    y = xf * lax.rsqrt(jnp.mean(xf * xf, axis=-1, keepdims=True) + EPS)
    return (y * g.astype(jnp.float32)).astype(x.dtype)


def layernorm(x, g, b):
    xf = x.astype(jnp.float32)
    mu = jnp.mean(xf, axis=-1, keepdims=True)
    var = jnp.mean(jnp.square(xf - mu), axis=-1, keepdims=True)
    y = (xf - mu) * lax.rsqrt(var + EPS)
    return (y * g.astype(jnp.float32) + b.astype(jnp.float32)).astype(x.dtype)


def partial_rope(t, positions):
    half = ROPE_DIM // 2
    inv = ROPE_THETA ** (-(jnp.arange(half, dtype=jnp.float32) * 2.0) / ROPE_DIM)
    ang = positions.astype(jnp.float32)[..., None] * inv
    cos = jnp.cos(ang)[:, :, None, :]
    sin = jnp.sin(ang)[:, :, None, :]
    t1 = t[..., :half].astype(jnp.float32)
    t2 = t[..., half:ROPE_DIM].astype(jnp.float32)
    r1 = (t1 * cos - t2 * sin).astype(t.dtype)
    r2 = (t2 * cos + t1 * sin).astype(t.dtype)
    return jnp.concatenate([r1, r2, t[..., ROPE_DIM:]], axis=-1)


def conformer_conv(val, glu_gate, w_dw, b_dw, g_ln, b_ln, w_pw, b_pw):
    u = val * jax.nn.sigmoid(glu_gate)
    u = lax.conv_general_dilated(
        u, w_dw.reshape(CONV_WIDTH, 1, D_CONV).astype(u.dtype),
        window_strides=(1,), padding=[(CONV_WIDTH - 1, 0)],
        dimension_numbers=("NWC", "WIO", "NWC"),
        feature_group_count=D_CONV) + b_dw
    u = jax.nn.silu(layernorm(u, g_ln, b_ln))
    return u @ w_pw + b_pw


def moba_attention(q, k, v):
    B, S, H, Dh = q.shape
    nb = -(-S // BLOCK)
    pad = nb * BLOCK - S
    q = q.transpose(0, 2, 1, 3)
    kp = jnp.pad(k.transpose(0, 2, 1, 3), ((0, 0), (0, 0), (0, pad), (0, 0)))
    vp = jnp.pad(v.transpose(0, 2, 1, 3), ((0, 0), (0, 0), (0, pad), (0, 0)))
    kb = kp.reshape(B, H, nb, BLOCK, Dh)
    vb = vp.reshape(B, H, nb, BLOCK, Dh)
    scale = Dh ** -0.5
    q_block = jnp.arange(S) // BLOCK
    n_sel = min(TOP_K, nb - 1)
    if n_sel > 0:
        kmean = jnp.mean(kb.astype(jnp.float32), axis=3)
        gate = jnp.einsum("bhsd,bhnd->bhsn", q.astype(jnp.float32), kmean)
        past = jnp.arange(nb)[None, :] < q_block[:, None]
        gate = jnp.where(past[None, None], gate, NEG)
        _, sel = lax.top_k(gate, n_sel)
        valid = jnp.arange(n_sel)[None, :] < q_block[:, None]
    bidx = jnp.arange(B)[:, None, None]
    hidx = jnp.arange(H)[None, :, None]

    def chunk(i):
        start = i * Q_CHUNK
        qc = lax.dynamic_slice_in_dim(q, start, Q_CHUNK, axis=2)
        tpos = start + jnp.arange(Q_CHUNK)
        own = start // BLOCK
        ko = lax.dynamic_slice_in_dim(kp, own * BLOCK, BLOCK, axis=2)
        vo = lax.dynamic_slice_in_dim(vp, own * BLOCK, BLOCK, axis=2)
        kpos = own * BLOCK + jnp.arange(BLOCK)
        lo = jnp.einsum("bhqd,bhkd->bhqk", qc, ko).astype(jnp.float32) * scale
        lo = jnp.where((kpos[None, :] <= tpos[:, None])[None, None], lo, NEG)
        logits = [lo]
        if n_sel > 0:
            selc = lax.dynamic_slice_in_dim(sel, start, Q_CHUNK, axis=2)
            validc = lax.dynamic_slice_in_dim(valid, start, Q_CHUNK, axis=0)
            for r in range(n_sel):
                kg = kb[bidx, hidx, selc[..., r]]
                lr = jnp.einsum("bhqd,bhqkd->bhqk", qc, kg).astype(jnp.float32) * scale
                logits.append(jnp.where(validc[None, None, :, r:r + 1], lr, NEG))
        probs = jax.nn.softmax(jnp.concatenate(logits, axis=-1), axis=-1).astype(vp.dtype)
        out = jnp.einsum("bhqk,bhkd->bhqd", probs[..., :BLOCK], vo)
        if n_sel > 0:
            for r in range(n_sel):
                vg = vb[bidx, hidx, selc[..., r]]
                pr = probs[..., (r + 1) * BLOCK:(r + 2) * BLOCK]
                out = out + jnp.einsum("bhqk,bhqkd->bhqd", pr, vg)
        return out

    outs = lax.map(chunk, jnp.arange(S // Q_CHUNK))
    return outs.transpose(1, 0, 3, 2, 4).reshape(B, S, H * Dh)


def setup_inputs(seed: int = 0) -> dict:
    key = jax.random.key(seed)
    ks = jax.random.split(key, 16)
    f32 = jnp.float32
    x = jax.random.normal(ks[0], (BATCH, SEQ, D_MODEL), f32)
    c = jax.random.normal(ks[1], (BATCH, D_MODEL), f32)
    positions = jnp.broadcast_to(jnp.arange(SEQ, dtype=jnp.int32), (BATCH, SEQ))
    w_ada = jax.random.normal(ks[2], (DEPTH, D_MODEL, 3 * D_MODEL), f32) * (0.5 * D_MODEL ** -0.5)
    b_ada = jax.random.normal(ks[3], (DEPTH, 3 * D_MODEL), f32) * 0.02
    g_norm = 1.0 + 0.02 * jax.random.normal(ks[4], (DEPTH, D_MODEL), f32)
    w_in = jax.random.normal(ks[5], (DEPTH, D_MODEL, D_IN), f32) * D_MODEL ** -0.5
    w_dw = jax.random.normal(ks[6], (DEPTH, CONV_WIDTH, D_CONV), f32) * CONV_WIDTH ** -0.5
    b_dw = jax.random.normal(ks[7], (DEPTH, D_CONV), f32) * 0.02
    g_ln_conv = 1.0 + 0.02 * jax.random.normal(ks[8], (DEPTH, D_CONV), f32)
    b_ln_conv = jax.random.normal(ks[9], (DEPTH, D_CONV), f32) * 0.02
    w_pw = jax.random.normal(ks[10], (DEPTH, D_CONV, D_CONV), f32) * D_CONV ** -0.5
    b_pw = jax.random.normal(ks[11], (DEPTH, D_CONV), f32) * 0.02
    w_out = jax.random.normal(ks[12], (DEPTH, D_MIX, D_MODEL), f32) * D_MIX ** -0.5
    g_final = 1.0 + 0.02 * jax.random.normal(ks[13], (D_MODEL,), f32)
    return {"x": x, "c": c, "positions": positions, "w_ada": w_ada, "b_ada": b_ada,
            "g_norm": g_norm, "w_in": w_in, "w_dw": w_dw, "b_dw": b_dw,
            "g_ln_conv": g_ln_conv, "b_ln_conv": b_ln_conv, "w_pw": w_pw, "b_pw": b_pw,
            "w_out": w_out, "g_final": g_final}


def reference(x, c, positions, w_ada, b_ada, g_norm, w_in, w_dw, b_dw, g_ln_conv,
              b_ln_conv, w_pw, b_pw, w_out, g_final):
    B, S, _ = x.shape
    cut = np.cumsum(SPLITS)[:-1].tolist()
    for l in range(DEPTH):
        mod = jax.nn.silu(c) @ w_ada[l] + b_ada[l]
        shift, scale, gate = jnp.split(mod, 3, axis=-1)
        h = rmsnorm(x, g_norm[l]) * (1.0 + scale[:, None, :]) + shift[:, None, :]
        proj = h @ w_in[l]
        c_val, c_glu, c_gate, q, k, v, a_gate = jnp.split(proj, cut, axis=-1)
        y_conv = conformer_conv(c_val, c_glu, w_dw[l], b_dw[l], g_ln_conv[l],
                                b_ln_conv[l], w_pw[l], b_pw[l]) * jax.nn.silu(c_gate)
        q = partial_rope(q.reshape(B, S, N_HEADS, HEAD_DIM), positions)
        k = partial_rope(k.reshape(B, S, N_HEADS, HEAD_DIM), positions)
        v = v.reshape(B, S, N_HEADS, HEAD_DIM)
        y_attn = moba_attention(q, k, v) * jax.nn.silu(a_gate)
        y = jnp.concatenate([y_conv, y_attn], axis=-1) @ w_out[l]
        x = x + gate[:, None, :] * y
    return rmsnorm(x, g_final)
```

```cpp
#include <hip/hip_runtime.h>
#include <hip/hip_cooperative_groups.h>
#include <cstdio>
#include <cstdint>
namespace cg = cooperative_groups;

constexpr int NB_ = 8, S_ = 4096, T_ = NB_ * S_, D_ = 1024, DIN = 3584, DC = 512, NH = 8, HD = 64, KB = 256, NKB = S_ / KB, CW = 31;
constexpr float EPS_ = 1e-6f;
constexpr float C2 = 0.125f * 1.4426950408889634f;

typedef unsigned short bf16;
typedef unsigned u32x4 __attribute__((ext_vector_type(4)));
typedef float f32x4 __attribute__((ext_vector_type(4)));

constexpr size_t MiB = 1u << 20;
constexpr size_t WS_CTL = 0;
constexpr size_t CTL_ZERO = 2 * MiB;
constexpr size_t WS_KMEAN = 1 * MiB;
constexpr size_t WS_MODP = 2 * MiB;
constexpr size_t WS_ROPE = 3 * MiB;
constexpr size_t WS_WIN = 6 * MiB;
constexpr size_t WS_WPW = 13 * MiB;
constexpr size_t WS_WOUT = 14 * MiB;
constexpr size_t WS_H = 16 * MiB;
constexpr size_t WS_U = 80 * MiB;
constexpr size_t WS_SGC = 112 * MiB;
constexpr size_t WS_Q = 144 * MiB;
constexpr size_t WS_K = 176 * MiB;
constexpr size_t WS_V = 208 * MiB;
constexpr size_t WS_SGA = 240 * MiB;
constexpr size_t WS_ALN = 272 * MiB;
constexpr size_t WS_YCAT = 304 * MiB;
constexpr size_t WS_P = 272 * MiB;
constexpr size_t WS_END = 496 * MiB;

constexpr int LDS_BYTES = 147456;

__device__ __forceinline__ float bf2f(unsigned b) { return __uint_as_float(b << 16); }
__device__ __forceinline__ unsigned f2bf(float f) { unsigned u = __float_as_uint(f); return (u + 0x7fffu + ((u >> 16) & 1u)) >> 16; }
__device__ __forceinline__ unsigned pk2(float lo, float hi) { return f2bf(lo) | (f2bf(hi) << 16); }
__device__ __forceinline__ float silu_f(float v) { return v / (1.f + __expf(-v)); }
__device__ __forceinline__ float sigm_f(float v) { return 1.f / (1.f + __expf(-v)); }
__device__ __forceinline__ float wave_sum(float v) {
#pragma unroll
    for (int o = 1; o < 64; o <<= 1) v += __shfl_xor(v, o);
    return v;
}
__device__ __forceinline__ float wave_max(float v) {
#pragma unroll
    for (int o = 1; o < 64; o <<= 1) v = fmaxf(v, __shfl_xor(v, o));
    return v;
}
__device__ __forceinline__ void unpack8(const u32x4 v, float (&f)[8]) {
    f[0] = bf2f(v.x & 0xffffu); f[1] = bf2f(v.x >> 16); f[2] = bf2f(v.y & 0xffffu); f[3] = bf2f(v.y >> 16);
    f[4] = bf2f(v.z & 0xffffu); f[5] = bf2f(v.z >> 16); f[6] = bf2f(v.w & 0xffffu); f[7] = bf2f(v.w >> 16);
}
__device__ __forceinline__ u32x4 pack8(const float (&f)[8]) {
    u32x4 o; o.x = pk2(f[0], f[1]); o.y = pk2(f[2], f[3]); o.z = pk2(f[4], f[5]); o.w = pk2(f[6], f[7]); return o;
}

struct Frame {
    unsigned char* lds;
    int tid, lane, wave, vcu, G;
    const float *x, *c, *w_ada, *b_ada, *g_norm, *w_in, *w_dw, *b_dw, *g_ln, *b_ln, *w_pw, *b_pw, *w_out, *g_final;
    const int* pos;
    float* out; unsigned char* ws;
};

__device__ __forceinline__ void p0_mod(Frame& F) {
    float* red = (float*)F.lds;
    float* MODP = (float*)(F.ws + WS_MODP);
    for (int it = F.vcu; it < 48 * 4; it += F.G) {
        const int cc = it % 48, q = it / 48, n = cc * 64 + F.lane, k0 = q * 256 + F.wave * 32;
        float acc[8];
#pragma unroll
        for (int b = 0; b < 8; ++b) acc[b] = 0.f;
#pragma unroll 8
        for (int kk = 0; kk < 32; ++kk) {
            const float w = F.w_ada[(size_t)(k0 + kk) * 3072 + n];
#pragma unroll
            for (int b = 0; b < 8; ++b) { const float cv = F.c[b * D_ + k0 + kk]; acc[b] += silu_f(cv) * w; }
        }
        __syncthreads();
#pragma unroll
        for (int b = 0; b < 8; ++b) red[(F.wave * 8 + b) * 64 + F.lane] = acc[b];
        __syncthreads();
        {
            float s = 0.f;
#pragma unroll
            for (int w = 0; w < 8; ++w) s += red[(w * 8 + F.wave) * 64 + F.lane];
            MODP[((size_t)q * 8 + F.wave) * 3072 + n] = s;
        }
    }
    __syncthreads();
}
__device__ __forceinline__ void p0_rope(Frame& F) {
    float* ROPE = (float*)(F.ws + WS_ROPE);
    const int gt = F.vcu * 512 + F.tid, NT = F.G * 512;
    for (int e = gt; e < T_ * 8; e += NT) {
        const int t = e >> 3, i = e & 7;
        const double inv = (i == 0) ? 1.0 : (i == 1) ? 0.19392274474868576 : (i == 2) ? 0.03760603093086393 : (i == 3) ? 0.007292664737217109 :
                           (i == 4) ? 0.001414213562373095 : (i == 5) ? 0.0002742481756762073 : (i == 6) ? 5.318295896944988e-05 : 1.031338537721246e-05;
        const double rev = (double)F.pos[t] * inv * 0.15915494309189535;
        const float fr = (float)(rev - floor(rev));
        ROPE[2 * e] = __builtin_amdgcn_cosf(fr); ROPE[2 * e + 1] = __builtin_amdgcn_sinf(fr);
    }
}
__device__ __forceinline__ float mod_at(Frame& F, int b, int n) {
    const float* MODP = (const float*)(F.ws + WS_MODP);
    float s = F.b_ada[n];
#pragma unroll
    for (int q = 0; q < 4; ++q) s += MODP[((size_t)q * 8 + b) * 3072 + n];
    return s;
}

__device__ __forceinline__ void p1_h(Frame& F) {
    bf16* Hb = (bf16*)(F.ws + WS_H);
    const int gw = F.vcu * 8 + F.wave, NGW = F.G * 8, RPW = 16;
    for (int blk = gw; blk < T_ / RPW; blk += NGW) {
        const int r0 = blk * RPW, b = r0 / S_;
        f32x4 gs[4], sh[4];
#pragma unroll
        for (int j = 0; j < 4; ++j) {
            const int k = 4 * F.lane + 256 * j;
            float g4[4], s4[4];
#pragma unroll
            for (int e = 0; e < 4; ++e) { g4[e] = F.g_norm[k + e] * (1.f + mod_at(F, b, 1024 + k + e)); s4[e] = mod_at(F, b, k + e); }
            gs[j] = (f32x4){g4[0], g4[1], g4[2], g4[3]}; sh[j] = (f32x4){s4[0], s4[1], s4[2], s4[3]};
        }
        for (int r = r0; r < r0 + RPW; ++r) {
            const f32x4* xr = (const f32x4*)(F.x + (size_t)r * D_) + F.lane;
            f32x4 v[4]; float s = 0.f;
#pragma unroll
            for (int j = 0; j < 4; ++j) { v[j] = xr[64 * j]; s += (v[j].x * v[j].x + v[j].y * v[j].y) + (v[j].z * v[j].z + v[j].w * v[j].w); }
            const float rstd = rsqrtf(wave_sum(s) * (1.f / D_) + EPS_);
            unsigned long long* o8 = (unsigned long long*)(Hb + (size_t)r * D_) + F.lane;
#pragma unroll
            for (int j = 0; j < 4; ++j) { const f32x4 h = v[j] * rstd * gs[j] + sh[j];
                o8[64 * j] = (unsigned long long)pk2(h.x, h.y) | ((unsigned long long)pk2(h.z, h.w) << 32); }
        }
    }
}

template <class Epi>
__device__ __forceinline__ void naive_gemm(Frame& F, const bf16* A, int lda, const float* W, int M, int N, int K, const Epi& epi) {
    float* As = (float*)F.lds;
    float* Bs = As + 32 * 132;
    const int tid = F.tid, ty = tid >> 4, tx = tid & 15;
    const int ntn = N / 128, ntiles = (M / 128) * ntn;
    const int arow = tid >> 2, akq = (tid & 3) * 8, bkk = tid >> 4, bn8 = (tid & 15) * 8;
    for (int tile = F.vcu; tile < ntiles; tile += F.G) {
        const int tm = tile / ntn, tn = tile % ntn;
        float acc[4][8];
#pragma unroll
        for (int i = 0; i < 4; ++i)
#pragma unroll
            for (int j = 0; j < 8; ++j) acc[i][j] = 0.f;
        for (int k0 = 0; k0 < K; k0 += 32) {
            const u32x4 av = *(const u32x4*)(A + (size_t)(tm * 128 + arow) * lda + k0 + akq);
            const f32x4 b0 = *(const f32x4*)(W + (size_t)(k0 + bkk) * N + tn * 128 + bn8);
            const f32x4 b1 = *(const f32x4*)(W + (size_t)(k0 + bkk) * N + tn * 128 + bn8 + 4);
            __syncthreads();
            float af[8]; unpack8(av, af);
#pragma unroll
            for (int i = 0; i < 8; ++i) As[(akq + i) * 132 + arow] = af[i];
            *(f32x4*)&Bs[bkk * 132 + bn8] = b0; *(f32x4*)&Bs[bkk * 132 + bn8 + 4] = b1;
            __syncthreads();
#pragma unroll 8
            for (int kk = 0; kk < 32; ++kk) {
                const f32x4 a4 = *(const f32x4*)&As[kk * 132 + ty * 4];
                const f32x4 c0 = *(const f32x4*)&Bs[kk * 132 + tx * 8], c1 = *(const f32x4*)&Bs[kk * 132 + tx * 8 + 4];
                const float a[4] = {a4.x, a4.y, a4.z, a4.w}; const float bb[8] = {c0.x, c0.y, c0.z, c0.w, c1.x, c1.y, c1.z, c1.w};
#pragma unroll
                for (int i = 0; i < 4; ++i)
#pragma unroll
                    for (int j = 0; j < 8; ++j) acc[i][j] += a[i] * bb[j];
            }
        }
#pragma unroll
        for (int i = 0; i < 4; ++i) epi(tm * 128 + ty * 4 + i, tn * 128 + tx * 8, acc[i]);
    }
    __syncthreads();
}
struct EpiStoreBf16 { bf16* O; int ldc;
    __device__ __forceinline__ void operator()(int row, int col, const float (&v)[8]) const { *(u32x4*)(O + (size_t)row * ldc + col) = pack8(v); } };
struct EpiPwNaive { bf16* O; const bf16* SGC; const float* bias;
    __device__ __forceinline__ void operator()(int row, int col, const float (&v)[8]) const {
        float g[8], o[8]; unpack8(*(const u32x4*)(SGC + (size_t)row * DC + col), g);
#pragma unroll
        for (int j = 0; j < 8; ++j) o[j] = (v[j] + bias[col + j]) * g[j];
        *(u32x4*)(O + (size_t)row * D_ + col) = pack8(o); } };
struct EpiOutNaive { float* O; const float* x; const float* modp; const float* b_ada;
    __device__ __forceinline__ void operator()(int row, int col, const float (&v)[8]) const {
        const int b = row / S_;
#pragma unroll
        for (int j = 0; j < 8; ++j) { float g = b_ada[2048 + col + j];
#pragma unroll
            for (int q = 0; q < 4; ++q) g += modp[((size_t)q * 8 + b) * 3072 + 2048 + col + j];
            O[(size_t)row * D_ + col + j] = x[(size_t)row * D_ + col + j] + g * v[j]; } } };

__device__ __forceinline__ void n2_transform(Frame& F) {
    const bf16* P = (const bf16*)(F.ws + WS_P); const float* ROPE = (const float*)(F.ws + WS_ROPE);
    bf16 *U = (bf16*)(F.ws + WS_U), *SGC = (bf16*)(F.ws + WS_SGC), *Q = (bf16*)(F.ws + WS_Q), *K = (bf16*)(F.ws + WS_K), *V = (bf16*)(F.ws + WS_V), *SGA = (bf16*)(F.ws + WS_SGA);
    const int gw = F.vcu * 8 + F.wave, NGW = F.G * 8, c8 = F.lane * 8;
    for (int t = gw; t < T_; t += NGW) {
        const bf16* pr = P + (size_t)t * DIN;
        float a[8], g[8], o[8];
        unpack8(*(const u32x4*)(pr + c8), a); unpack8(*(const u32x4*)(pr + 512 + c8), g);
#pragma unroll
        for (int j = 0; j < 8; ++j) o[j] = a[j] * sigm_f(g[j]);
        *(u32x4*)(U + (size_t)t * DC + c8) = pack8(o);
        unpack8(*(const u32x4*)(pr + 1024 + c8), a);
#pragma unroll
        for (int j = 0; j < 8; ++j) o[j] = silu_f(a[j]);
        *(u32x4*)(SGC + (size_t)t * DC + c8) = pack8(o);
        float cs[8], sn[8];
#pragma unroll
        for (int j = 0; j < 8; ++j) { cs[j] = ROPE[((size_t)t * 8 + j) * 2]; sn[j] = ROPE[((size_t)t * 8 + j) * 2 + 1]; }
#pragma unroll
        for (int which = 0; which < 2; ++which) {
            unpack8(*(const u32x4*)(pr + (which ? 2048 : 1536) + c8), a);
            float p[8];
#pragma unroll
            for (int j = 0; j < 8; ++j) p[j] = __shfl_xor(a[j], 1);
            const int l7 = F.lane & 7;
#pragma unroll
            for (int j = 0; j < 8; ++j) { float r = a[j];
                if (l7 == 0) r = a[j] * cs[j] - p[j] * sn[j];
                else if (l7 == 1) r = a[j] * cs[j] + p[j] * sn[j];
                o[j] = which ? r : r * C2; }
            *(u32x4*)((which ? K : Q) + (size_t)t * DC + c8) = pack8(o);
        }
        *(u32x4*)(V + (size_t)t * DC + c8) = *(const u32x4*)(pr + 2560 + c8);
        unpack8(*(const u32x4*)(pr + 3072 + c8), a);
#pragma unroll
        for (int j = 0; j < 8; ++j) o[j] = silu_f(a[j]);
        *(u32x4*)(SGA + (size_t)t * DC + c8) = pack8(o);
    }
}
__device__ __forceinline__ void n2_kmean(Frame& F) {
    const bf16* K = (const bf16*)(F.ws + WS_K); float* KM = (float*)(F.ws + WS_KMEAN);
    const int gt = F.vcu * 512 + F.tid, NT = F.G * 512;
    for (int e = gt; e < NB_ * NKB * DC; e += NT) {
        const int col = e % DC, blk = (e / DC) % NKB, b = e / (DC * NKB);
        float s = 0.f;
        for (int r = 0; r < KB; ++r) s += bf2f(K[(size_t)(b * S_ + blk * KB + r) * DC + col]);
        KM[(((size_t)b * NH + col / HD) * NKB + blk) * HD + (col % HD)] = s * (1.f / KB);
    }
}

__device__ __forceinline__ void n3_conv(Frame& F) {
    const bf16* U = (const bf16*)(F.ws + WS_U); bf16* ALN = (bf16*)(F.ws + WS_ALN);
    const int gw = F.vcu * 8 + F.wave, NGW = F.G * 8, c8 = F.lane * 8;
    for (int t = gw; t < T_; t += NGW) {
        const int s = t % S_;
        float acc[8];
        { const f32x4 b0 = *(const f32x4*)(F.b_dw + c8), b1 = *(const f32x4*)(F.b_dw + c8 + 4);
          acc[0] = b0.x; acc[1] = b0.y; acc[2] = b0.z; acc[3] = b0.w; acc[4] = b1.x; acc[5] = b1.y; acc[6] = b1.z; acc[7] = b1.w; }
        for (int w = 0; w < CW; ++w) {
            const int sp = s - (CW - 1) + w;
            if (sp < 0) continue;
            float u[8]; unpack8(*(const u32x4*)(U + (size_t)(t - (CW - 1) + w) * DC + c8), u);
            const f32x4 k0 = *(const f32x4*)(F.w_dw + w * DC + c8), k1 = *(const f32x4*)(F.w_dw + w * DC + c8 + 4);
            acc[0] += u[0] * k0.x; acc[1] += u[1] * k0.y; acc[2] += u[2] * k0.z; acc[3] += u[3] * k0.w;
            acc[4] += u[4] * k1.x; acc[5] += u[5] * k1.y; acc[6] += u[6] * k1.z; acc[7] += u[7] * k1.w;
        }
        float sm = 0.f;
#pragma unroll
        for (int j = 0; j < 8; ++j) sm += acc[j];
        const float mu = wave_sum(sm) * (1.f / DC);
        float sq = 0.f;
#pragma unroll
        for (int j = 0; j < 8; ++j) { acc[j] -= mu; sq += acc[j] * acc[j]; }
        const float rstd = rsqrtf(wave_sum(sq) * (1.f / DC) + EPS_);
        float o[8];
#pragma unroll
        for (int j = 0; j < 8; ++j) o[j] = silu_f(acc[j] * rstd * F.g_ln[c8 + j] + F.b_ln[c8 + j]);
        *(u32x4*)(ALN + (size_t)t * DC + c8) = pack8(o);
    }
}

__device__ __forceinline__ void n3_attn(Frame& F) {
    const bf16 *Q = (const bf16*)(F.ws + WS_Q), *K = (const bf16*)(F.ws + WS_K), *V = (const bf16*)(F.ws + WS_V), *SGA = (const bf16*)(F.ws + WS_SGA);
    const float* KM = (const float*)(F.ws + WS_KMEAN); bf16* Y = (bf16*)(F.ws + WS_YCAT);
    float* qs = (float*)F.lds + F.wave * 64;
    float* ps = (float*)F.lds + 512 + F.wave * 1024;
    const int gw = F.vcu * 8 + F.wave, NGW = F.G * 8, lane = F.lane;
    for (int it = gw; it < T_ * NH; it += NGW) {
        const int h = it % NH, t = it / NH, b = t / S_, s = t % S_, qb = s / KB;
        const float qv = bf2f(Q[(size_t)t * DC + h * HD + lane]);
        qs[lane] = qv;
        __builtin_amdgcn_s_waitcnt(0); __builtin_amdgcn_wave_barrier();
        float gate = -3.0e38f;
        if (lane < qb) { const float* km = KM + (((size_t)b * NH + h) * NKB + lane) * HD; float g = 0.f;
            for (int d = 0; d < HD; ++d) g += qs[d] * km[d];
            gate = g; }
        int sel0 = -1, sel1 = -1, sel2 = -1;
        {
            float g0 = -3.0e38f, g1 = -3.0e38f, g2 = -3.0e38f;
            for (int j = 0; j < NKB; ++j) { const float gj = __shfl(gate, j);
                if (j < qb) {
                    if (gj > g0) { g2 = g1; sel2 = sel1; g1 = g0; sel1 = sel0; g0 = gj; sel0 = j; }
                    else if (gj > g1) { g2 = g1; sel2 = sel1; g1 = gj; sel1 = j; }
                    else if (gj > g2) { g2 = gj; sel2 = j; } } }
        }
        float lg[4][4]; float mx = -3.0e38f;
#pragma unroll
        for (int sl = 0; sl < 4; ++sl) {
            const int blk = (sl == 0) ? qb : (sl == 1) ? sel0 : (sl == 2) ? sel1 : sel2;
#pragma unroll
            for (int kk = 0; kk < 4; ++kk) {
                const int key = lane + 64 * kk; float l = -3.0e38f;
                if (blk >= 0 && (sl > 0 || blk * KB + key <= s)) {
                    const bf16* kr = K + (size_t)(b * S_ + blk * KB + key) * DC + h * HD; float a = 0.f;
#pragma unroll
                    for (int d8 = 0; d8 < 8; ++d8) { float kf[8]; unpack8(*(const u32x4*)(kr + d8 * 8), kf);
#pragma unroll
                        for (int e = 0; e < 8; ++e) a += qs[d8 * 8 + e] * kf[e]; }
                    l = a; }
                lg[sl][kk] = l; mx = fmaxf(mx, l);
            }
        }
        mx = wave_max(mx);
        float sum = 0.f;
#pragma unroll
        for (int sl = 0; sl < 4; ++sl)
#pragma unroll
            for (int kk = 0; kk < 4; ++kk) { const float p = (lg[sl][kk] > -1.0e38f) ? exp2f(lg[sl][kk] - mx) : 0.f; sum += p; ps[sl * 256 + lane + 64 * kk] = bf2f(f2bf(p)); }
        sum = wave_sum(sum);
        __builtin_amdgcn_s_waitcnt(0); __builtin_amdgcn_wave_barrier();
        float o = 0.f;
#pragma unroll
        for (int sl = 0; sl < 4; ++sl) {
            const int blk = (sl == 0) ? qb : (sl == 1) ? sel0 : (sl == 2) ? sel1 : sel2;
            if (blk < 0) continue;
            const int nk = (sl == 0) ? (s - qb * KB + 1) : KB;
            const bf16* vr = V + (size_t)(b * S_ + blk * KB) * DC + h * HD + lane;
            for (int key = 0; key < nk; ++key) o += ps[sl * 256 + key] * bf2f(vr[(size_t)key * DC]);
        }
        const float y = o / sum * bf2f(SGA[(size_t)t * DC + h * HD + lane]);
        Y[(size_t)t * D_ + DC + h * HD + lane] = (bf16)f2bf(y);
        __builtin_amdgcn_s_waitcnt(0); __builtin_amdgcn_wave_barrier();
    }
}

__device__ __forceinline__ void p6_final(Frame& F) {
    const int gw = F.vcu * 8 + F.wave, NGW = F.G * 8;
    f32x4 g[4];
#pragma unroll
    for (int j = 0; j < 4; ++j) g[j] = *((const f32x4*)F.g_final + F.lane + 64 * j);
    for (int r = gw; r < T_; r += NGW) {
        f32x4* xr = (f32x4*)(F.out + (size_t)r * D_) + F.lane;
        f32x4 v[4]; float s = 0.f;
#pragma unroll
        for (int j = 0; j < 4; ++j) { v[j] = xr[64 * j]; s += (v[j].x * v[j].x + v[j].y * v[j].y) + (v[j].z * v[j].z + v[j].w * v[j].w); }
        const float rstd = rsqrtf(wave_sum(s) * (1.f / D_) + EPS_);
#pragma unroll
        for (int j = 0; j < 4; ++j) xr[64 * j] = v[j] * rstd * g[j];
    }
}

struct Args { const void* in[15]; float* out; unsigned char* ws; int ph_lo, ph_hi; };
constexpr int NPH = 9;

__global__ void __launch_bounds__(512, 2) mk_fwd(Args args) {
    extern __shared__ __attribute__((aligned(16))) unsigned char lds[];
    Frame F;
    F.lds = lds; F.tid = threadIdx.x; F.lane = F.tid & 63; F.wave = __builtin_amdgcn_readfirstlane(F.tid >> 6);
    F.G = gridDim.x; { const int bx = blockIdx.x; F.vcu = (F.G % 8 == 0) ? (bx % 8) * (F.G / 8) + bx / 8 : bx; }
    F.x = (const float*)args.in[0]; F.c = (const float*)args.in[1]; F.pos = (const int*)args.in[2]; F.w_ada = (const float*)args.in[3]; F.b_ada = (const float*)args.in[4];
    F.g_norm = (const float*)args.in[5]; F.w_in = (const float*)args.in[6]; F.w_dw = (const float*)args.in[7]; F.b_dw = (const float*)args.in[8];
    F.g_ln = (const float*)args.in[9]; F.b_ln = (const float*)args.in[10]; F.w_pw = (const float*)args.in[11]; F.b_pw = (const float*)args.in[12];
    F.w_out = (const float*)args.in[13]; F.g_final = (const float*)args.in[14];
    F.out = args.out; F.ws = args.ws;
    const int lo = args.ph_lo, hi = args.ph_hi;
#define IN(k) (lo <= (k) && (k) < hi)
    if (IN(0)) { p0_mod(F); p0_rope(F); }
    if (IN(1)) p1_h(F);
    if (IN(2)) { EpiStoreBf16 E{(bf16*)(F.ws + WS_P), DIN}; naive_gemm(F, (const bf16*)(F.ws + WS_H), D_, F.w_in, T_, DIN, D_, E); }
    if (IN(3)) n2_transform(F);
    if (IN(4)) n2_kmean(F);
    if (IN(5)) { n3_conv(F); n3_attn(F); }
    if (IN(6)) { EpiPwNaive E{(bf16*)(F.ws + WS_YCAT), (const bf16*)(F.ws + WS_SGC), F.b_pw}; naive_gemm(F, (const bf16*)(F.ws + WS_ALN), DC, F.w_pw, T_, DC, DC, E); }
    if (IN(7)) { EpiOutNaive E{F.out, F.x, (const float*)(F.ws + WS_MODP), F.b_ada}; naive_gemm(F, (const bf16*)(F.ws + WS_YCAT), D_, F.w_out, T_, D_, D_, E); }
    if (IN(8)) p6_final(F);
#undef IN
}

extern "C" void kernel_launch(void* const* d_in, const int* in_sizes, int n_in, void* d_out, int out_size, void* d_ws, size_t ws_size, hipStream_t stream) {
    static int grid = 0;
    if (grid == 0) {
        if (n_in != 15 || out_size != T_ * D_ || ws_size < WS_END) { fprintf(stderr, "kernel_launch: unexpected problem (n_in %d out %d ws %zu)\n", n_in, out_size, ws_size); grid = -1; return; }
        int dev = 0, cus = 0, per_cu = 0;
        hipGetDevice(&dev); hipDeviceGetAttribute(&cus, hipDeviceAttributeMultiprocessorCount, dev);
        hipFuncSetAttribute((const void*)mk_fwd, hipFuncAttributeMaxDynamicSharedMemorySize, LDS_BYTES);
        hipOccupancyMaxActiveBlocksPerMultiprocessor(&per_cu, (const void*)mk_fwd, 512, LDS_BYTES);
        if (per_cu < 1) per_cu = 1;
        (void)hipGetLastError();
        grid = cus;
    }
    if (grid < 0) return;
    hipMemsetAsync((char*)d_ws + WS_CTL, 0, CTL_ZERO, stream);
    Args a{};
    for (int i = 0; i < 15; ++i) a.in[i] = d_in[i];
    a.out = (float*)d_out; a.ws = (unsigned char*)d_ws;
    for (int p = 0; p < NPH; ++p) {
        a.ph_lo = p; a.ph_hi = p + 1;
        hipLaunchKernelGGL(mk_fwd, dim3(grid), dim3(512), LDS_BYTES, stream, a);
    }
}
```

```cpp
#include <hip/hip_runtime.h>
#include <hip/hip_cooperative_groups.h>
#include <cstdio>
#include <cstdint>
namespace cg = cooperative_groups;

constexpr int NB_ = 8, S_ = 4096, T_ = NB_ * S_, D_ = 1024, DIN = 3584, DC = 512, NH = 8, HD = 64, KB = 256, NKB = S_ / KB, CW = 31;
constexpr float EPS_ = 1e-6f;
constexpr float C2 = 0.125f * 1.4426950408889634f;

typedef unsigned short bf16;
typedef unsigned u32x4 __attribute__((ext_vector_type(4)));
typedef float f32x4 __attribute__((ext_vector_type(4)));

constexpr size_t MiB = 1u << 20;
constexpr size_t WS_CTL = 0;
constexpr size_t CTL_ZERO = 2 * MiB;
constexpr size_t WS_KMEAN = 1 * MiB;
constexpr size_t WS_MODP = 2 * MiB;
constexpr size_t WS_ROPE = 3 * MiB;
constexpr size_t WS_WIN = 6 * MiB;
constexpr size_t WS_WPW = 13 * MiB;
constexpr size_t WS_WOUT = 14 * MiB;
constexpr size_t WS_H = 16 * MiB;
constexpr size_t WS_U = 80 * MiB;
constexpr size_t WS_SGC = 112 * MiB;
constexpr size_t WS_Q = 144 * MiB;
constexpr size_t WS_K = 176 * MiB;
constexpr size_t WS_V = 208 * MiB;
constexpr size_t WS_SGA = 240 * MiB;
constexpr size_t WS_ALN = 272 * MiB;
constexpr size_t WS_YCAT = 304 * MiB;
constexpr size_t WS_P = 272 * MiB;
constexpr size_t WS_END = 496 * MiB;

constexpr int LDS_BYTES = 147456;

__device__ __forceinline__ float bf2f(unsigned b) { return __uint_as_float(b << 16); }
__device__ __forceinline__ unsigned f2bf(float f) { unsigned u = __float_as_uint(f); return (u + 0x7fffu + ((u >> 16) & 1u)) >> 16; }
__device__ __forceinline__ unsigned pk2(float lo, float hi) { return f2bf(lo) | (f2bf(hi) << 16); }
__device__ __forceinline__ float silu_f(float v) { return v / (1.f + __expf(-v)); }
__device__ __forceinline__ float sigm_f(float v) { return 1.f / (1.f + __expf(-v)); }
__device__ __forceinline__ float wave_sum(float v) {
#pragma unroll
    for (int o = 1; o < 64; o <<= 1) v += __shfl_xor(v, o);
    return v;
}
__device__ __forceinline__ float wave_max(float v) {
#pragma unroll
    for (int o = 1; o < 64; o <<= 1) v = fmaxf(v, __shfl_xor(v, o));
    return v;
}
__device__ __forceinline__ void unpack8(const u32x4 v, float (&f)[8]) {
    f[0] = bf2f(v.x & 0xffffu); f[1] = bf2f(v.x >> 16); f[2] = bf2f(v.y & 0xffffu); f[3] = bf2f(v.y >> 16);
    f[4] = bf2f(v.z & 0xffffu); f[5] = bf2f(v.z >> 16); f[6] = bf2f(v.w & 0xffffu); f[7] = bf2f(v.w >> 16);
}
__device__ __forceinline__ u32x4 pack8(const float (&f)[8]) {
    u32x4 o; o.x = pk2(f[0], f[1]); o.y = pk2(f[2], f[3]); o.z = pk2(f[4], f[5]); o.w = pk2(f[6], f[7]); return o;
}

struct Frame {
    unsigned char* lds;
    int tid, lane, wave, vcu, G;
    const float *x, *c, *w_ada, *b_ada, *g_norm, *w_in, *w_dw, *b_dw, *g_ln, *b_ln, *w_pw, *b_pw, *w_out, *g_final;
    const int* pos;
    float* out; unsigned char* ws;
};

__device__ __forceinline__ void p0_mod(Frame& F) {
    float* red = (float*)F.lds;
    float* MODP = (float*)(F.ws + WS_MODP);
    for (int it = F.vcu; it < 48 * 4; it += F.G) {
        const int cc = it % 48, q = it / 48, n = cc * 64 + F.lane, k0 = q * 256 + F.wave * 32;
        float acc[8];
#pragma unroll
        for (int b = 0; b < 8; ++b) acc[b] = 0.f;
#pragma unroll 8
        for (int kk = 0; kk < 32; ++kk) {
            const float w = F.w_ada[(size_t)(k0 + kk) * 3072 + n];
#pragma unroll
            for (int b = 0; b < 8; ++b) { const float cv = F.c[b * D_ + k0 + kk]; acc[b] += silu_f(cv) * w; }
        }
        __syncthreads();
#pragma unroll
        for (int b = 0; b < 8; ++b) red[(F.wave * 8 + b) * 64 + F.lane] = acc[b];
        __syncthreads();
        {
            float s = 0.f;
#pragma unroll
            for (int w = 0; w < 8; ++w) s += red[(w * 8 + F.wave) * 64 + F.lane];
            MODP[((size_t)q * 8 + F.wave) * 3072 + n] = s;
        }
    }
    __syncthreads();
}
__device__ __forceinline__ void p0_rope(Frame& F) {
    float* ROPE = (float*)(F.ws + WS_ROPE);
    const int gt = F.vcu * 512 + F.tid, NT = F.G * 512;
    for (int e = gt; e < T_ * 8; e += NT) {
        const int t = e >> 3, i = e & 7;
        const double inv = (i == 0) ? 1.0 : (i == 1) ? 0.19392274474868576 : (i == 2) ? 0.03760603093086393 : (i == 3) ? 0.007292664737217109 :
                           (i == 4) ? 0.001414213562373095 : (i == 5) ? 0.0002742481756762073 : (i == 6) ? 5.318295896944988e-05 : 1.031338537721246e-05;
        const double rev = (double)F.pos[t] * inv * 0.15915494309189535;
        const float fr = (float)(rev - floor(rev));
        ROPE[2 * e] = __builtin_amdgcn_cosf(fr); ROPE[2 * e + 1] = __builtin_amdgcn_sinf(fr);
    }
}
__device__ __forceinline__ float mod_at(Frame& F, int b, int n) {
    const float* MODP = (const float*)(F.ws + WS_MODP);
    float s = F.b_ada[n];
#pragma unroll
    for (int q = 0; q < 4; ++q) s += MODP[((size_t)q * 8 + b) * 3072 + n];
    return s;
}

__device__ __forceinline__ void p1_h(Frame& F) {
    bf16* Hb = (bf16*)(F.ws + WS_H);
    const int gw = F.vcu * 8 + F.wave, NGW = F.G * 8, RPW = 16;
    for (int blk = gw; blk < T_ / RPW; blk += NGW) {
        const int r0 = blk * RPW, b = r0 / S_;
        f32x4 gs[4], sh[4];
#pragma unroll
        for (int j = 0; j < 4; ++j) {
            const int k = 4 * F.lane + 256 * j;
            float g4[4], s4[4];
#pragma unroll
            for (int e = 0; e < 4; ++e) { g4[e] = F.g_norm[k + e] * (1.f + mod_at(F, b, 1024 + k + e)); s4[e] = mod_at(F, b, k + e); }
            gs[j] = (f32x4){g4[0], g4[1], g4[2], g4[3]}; sh[j] = (f32x4){s4[0], s4[1], s4[2], s4[3]};
        }
        for (int r = r0; r < r0 + RPW; ++r) {
            const f32x4* xr = (const f32x4*)(F.x + (size_t)r * D_) + F.lane;
            f32x4 v[4]; float s = 0.f;
#pragma unroll
            for (int j = 0; j < 4; ++j) { v[j] = xr[64 * j]; s += (v[j].x * v[j].x + v[j].y * v[j].y) + (v[j].z * v[j].z + v[j].w * v[j].w); }
            const float rstd = rsqrtf(wave_sum(s) * (1.f / D_) + EPS_);
            unsigned long long* o8 = (unsigned long long*)(Hb + (size_t)r * D_) + F.lane;
#pragma unroll
            for (int j = 0; j < 4; ++j) { const f32x4 h = v[j] * rstd * gs[j] + sh[j];
                o8[64 * j] = (unsigned long long)pk2(h.x, h.y) | ((unsigned long long)pk2(h.z, h.w) << 32); }
        }
    }
}

template <class Epi>
__device__ __forceinline__ void naive_gemm(Frame& F, const bf16* A, int lda, const float* W, int M, int N, int K, const Epi& epi) {
    float* As = (float*)F.lds;
    float* Bs = As + 32 * 132;
    const int tid = F.tid, ty = tid >> 4, tx = tid & 15;
    const int ntn = N / 128, ntiles = (M / 128) * ntn;
    const int arow = tid >> 2, akq = (tid & 3) * 8, bkk = tid >> 4, bn8 = (tid & 15) * 8;
    for (int tile = F.vcu; tile < ntiles; tile += F.G) {
        const int tm = tile / ntn, tn = tile % ntn;
        float acc[4][8];
#pragma unroll
        for (int i = 0; i < 4; ++i)
#pragma unroll
            for (int j = 0; j < 8; ++j) acc[i][j] = 0.f;
        for (int k0 = 0; k0 < K; k0 += 32) {
            const u32x4 av = *(const u32x4*)(A + (size_t)(tm * 128 + arow) * lda + k0 + akq);
            const f32x4 b0 = *(const f32x4*)(W + (size_t)(k0 + bkk) * N + tn * 128 + bn8);
            const f32x4 b1 = *(const f32x4*)(W + (size_t)(k0 + bkk) * N + tn * 128 + bn8 + 4);
            __syncthreads();
            float af[8]; unpack8(av, af);
#pragma unroll
            for (int i = 0; i < 8; ++i) As[(akq + i) * 132 + arow] = af[i];
            *(f32x4*)&Bs[bkk * 132 + bn8] = b0; *(f32x4*)&Bs[bkk * 132 + bn8 + 4] = b1;
            __syncthreads();
#pragma unroll 8
            for (int kk = 0; kk < 32; ++kk) {
                const f32x4 a4 = *(const f32x4*)&As[kk * 132 + ty * 4];
                const f32x4 c0 = *(const f32x4*)&Bs[kk * 132 + tx * 8], c1 = *(const f32x4*)&Bs[kk * 132 + tx * 8 + 4];
                const float a[4] = {a4.x, a4.y, a4.z, a4.w}; const float bb[8] = {c0.x, c0.y, c0.z, c0.w, c1.x, c1.y, c1.z, c1.w};
#pragma unroll
                for (int i = 0; i < 4; ++i)
#pragma unroll
                    for (int j = 0; j < 8; ++j) acc[i][j] += a[i] * bb[j];
            }
        }
#pragma unroll
        for (int i = 0; i < 4; ++i) epi(tm * 128 + ty * 4 + i, tn * 128 + tx * 8, acc[i]);
    }
    __syncthreads();
}
struct EpiStoreBf16 { bf16* O; int ldc;
    __device__ __forceinline__ void operator()(int row, int col, const float (&v)[8]) const { *(u32x4*)(O + (size_t)row * ldc + col) = pack8(v); } };
struct EpiPwNaive { bf16* O; const bf16* SGC; const float* bias;
    __device__ __forceinline__ void operator()(int row, int col, const float (&v)[8]) const {
        float g[8], o[8]; unpack8(*(const u32x4*)(SGC + (size_t)row * DC + col), g);
#pragma unroll
        for (int j = 0; j < 8; ++j) o[j] = (v[j] + bias[col + j]) * g[j];
        *(u32x4*)(O + (size_t)row * D_ + col) = pack8(o); } };
struct EpiOutNaive { float* O; const float* x; const float* modp; const float* b_ada;
    __device__ __forceinline__ void operator()(int row, int col, const float (&v)[8]) const {
        const int b = row / S_;
#pragma unroll
        for (int j = 0; j < 8; ++j) { float g = b_ada[2048 + col + j];
#pragma unroll
            for (int q = 0; q < 4; ++q) g += modp[((size_t)q * 8 + b) * 3072 + 2048 + col + j];
            O[(size_t)row * D_ + col + j] = x[(size_t)row * D_ + col + j] + g * v[j]; } } };

__device__ __forceinline__ void n2_transform(Frame& F) {
    const bf16* P = (const bf16*)(F.ws + WS_P); const float* ROPE = (const float*)(F.ws + WS_ROPE);
    bf16 *U = (bf16*)(F.ws + WS_U), *SGC = (bf16*)(F.ws + WS_SGC), *Q = (bf16*)(F.ws + WS_Q), *K = (bf16*)(F.ws + WS_K), *V = (bf16*)(F.ws + WS_V), *SGA = (bf16*)(F.ws + WS_SGA);
    const int gw = F.vcu * 8 + F.wave, NGW = F.G * 8, c8 = F.lane * 8;
    for (int t = gw; t < T_; t += NGW) {
        const bf16* pr = P + (size_t)t * DIN;
        float a[8], g[8], o[8];
        unpack8(*(const u32x4*)(pr + c8), a); unpack8(*(const u32x4*)(pr + 512 + c8), g);
#pragma unroll
        for (int j = 0; j < 8; ++j) o[j] = a[j] * sigm_f(g[j]);
        *(u32x4*)(U + (size_t)t * DC + c8) = pack8(o);
        unpack8(*(const u32x4*)(pr + 1024 + c8), a);
#pragma unroll
        for (int j = 0; j < 8; ++j) o[j] = silu_f(a[j]);
        *(u32x4*)(SGC + (size_t)t * DC + c8) = pack8(o);
        float cs[8], sn[8];
#pragma unroll
        for (int j = 0; j < 8; ++j) { cs[j] = ROPE[((size_t)t * 8 + j) * 2]; sn[j] = ROPE[((size_t)t * 8 + j) * 2 + 1]; }
#pragma unroll
        for (int which = 0; which < 2; ++which) {
            unpack8(*(const u32x4*)(pr + (which ? 2048 : 1536) + c8), a);
            float p[8];
#pragma unroll
            for (int j = 0; j < 8; ++j) p[j] = __shfl_xor(a[j], 1);
            const int l7 = F.lane & 7;
#pragma unroll
            for (int j = 0; j < 8; ++j) { float r = a[j];
                if (l7 == 0) r = a[j] * cs[j] - p[j] * sn[j];
                else if (l7 == 1) r = a[j] * cs[j] + p[j] * sn[j];
                o[j] = which ? r : r * C2; }
            *(u32x4*)((which ? K : Q) + (size_t)t * DC + c8) = pack8(o);
        }
        *(u32x4*)(V + (size_t)t * DC + c8) = *(const u32x4*)(pr + 2560 + c8);
        unpack8(*(const u32x4*)(pr + 3072 + c8), a);
#pragma unroll
        for (int j = 0; j < 8; ++j) o[j] = silu_f(a[j]);
        *(u32x4*)(SGA + (size_t)t * DC + c8) = pack8(o);
    }
}
__device__ __forceinline__ void n2_kmean(Frame& F) {
    const bf16* K = (const bf16*)(F.ws + WS_K); float* KM = (float*)(F.ws + WS_KMEAN);
    const int gt = F.vcu * 512 + F.tid, NT = F.G * 512;
    for (int e = gt; e < NB_ * NKB * DC; e += NT) {
        const int col = e % DC, blk = (e / DC) % NKB, b = e / (DC * NKB);
        float s = 0.f;
        for (int r = 0; r < KB; ++r) s += bf2f(K[(size_t)(b * S_ + blk * KB + r) * DC + col]);
        KM[(((size_t)b * NH + col / HD) * NKB + blk) * HD + (col % HD)] = s * (1.f / KB);
    }
}

__device__ __forceinline__ void n3_conv(Frame& F) {
    const bf16* U = (const bf16*)(F.ws + WS_U); bf16* ALN = (bf16*)(F.ws + WS_ALN);
    const int gw = F.vcu * 8 + F.wave, NGW = F.G * 8, c8 = F.lane * 8;
    for (int t = gw; t < T_; t += NGW) {
        const int s = t % S_;
        float acc[8];
        { const f32x4 b0 = *(const f32x4*)(F.b_dw + c8), b1 = *(const f32x4*)(F.b_dw + c8 + 4);
          acc[0] = b0.x; acc[1] = b0.y; acc[2] = b0.z; acc[3] = b0.w; acc[4] = b1.x; acc[5] = b1.y; acc[6] = b1.z; acc[7] = b1.w; }
        for (int w = 0; w < CW; ++w) {
            const int sp = s - (CW - 1) + w;
            if (sp < 0) continue;
            float u[8]; unpack8(*(const u32x4*)(U + (size_t)(t - (CW - 1) + w) * DC + c8), u);
            const f32x4 k0 = *(const f32x4*)(F.w_dw + w * DC + c8), k1 = *(const f32x4*)(F.w_dw + w * DC + c8 + 4);
            acc[0] += u[0] * k0.x; acc[1] += u[1] * k0.y; acc[2] += u[2] * k0.z; acc[3] += u[3] * k0.w;
            acc[4] += u[4] * k1.x; acc[5] += u[5] * k1.y; acc[6] += u[6] * k1.z; acc[7] += u[7] * k1.w;
        }
        float sm = 0.f;
#pragma unroll
        for (int j = 0; j < 8; ++j) sm += acc[j];
        const float mu = wave_sum(sm) * (1.f / DC);
        float sq = 0.f;
#pragma unroll
        for (int j = 0; j < 8; ++j) { acc[j] -= mu; sq += acc[j] * acc[j]; }
        const float rstd = rsqrtf(wave_sum(sq) * (1.f / DC) + EPS_);
        float o[8];
#pragma unroll
        for (int j = 0; j < 8; ++j) o[j] = silu_f(acc[j] * rstd * F.g_ln[c8 + j] + F.b_ln[c8 + j]);
        *(u32x4*)(ALN + (size_t)t * DC + c8) = pack8(o);
    }
}

__device__ __forceinline__ void n3_attn(Frame& F) {
    const bf16 *Q = (const bf16*)(F.ws + WS_Q), *K = (const bf16*)(F.ws + WS_K), *V = (const bf16*)(F.ws + WS_V), *SGA = (const bf16*)(F.ws + WS_SGA);
    const float* KM = (const float*)(F.ws + WS_KMEAN); bf16* Y = (bf16*)(F.ws + WS_YCAT);
    float* qs = (float*)F.lds + F.wave * 64;
    float* ps = (float*)F.lds + 512 + F.wave * 1024;
    const int gw = F.vcu * 8 + F.wave, NGW = F.G * 8, lane = F.lane;
    for (int it = gw; it < T_ * NH; it += NGW) {
        const int h = it % NH, t = it / NH, b = t / S_, s = t % S_, qb = s / KB;
        const float qv = bf2f(Q[(size_t)t * DC + h * HD + lane]);
        qs[lane] = qv;
        __builtin_amdgcn_s_waitcnt(0); __builtin_amdgcn_wave_barrier();
        float gate = -3.0e38f;
        if (lane < qb) { const float* km = KM + (((size_t)b * NH + h) * NKB + lane) * HD; float g = 0.f;
            for (int d = 0; d < HD; ++d) g += qs[d] * km[d];
            gate = g; }
        int sel0 = -1, sel1 = -1, sel2 = -1;
        {
            float g0 = -3.0e38f, g1 = -3.0e38f, g2 = -3.0e38f;
            for (int j = 0; j < NKB; ++j) { const float gj = __shfl(gate, j);
                if (j < qb) {
                    if (gj > g0) { g2 = g1; sel2 = sel1; g1 = g0; sel1 = sel0; g0 = gj; sel0 = j; }
                    else if (gj > g1) { g2 = g1; sel2 = sel1; g1 = gj; sel1 = j; }
                    else if (gj > g2) { g2 = gj; sel2 = j; } } }
        }
        float lg[4][4]; float mx = -3.0e38f;
#pragma unroll
        for (int sl = 0; sl < 4; ++sl) {
            const int blk = (sl == 0) ? qb : (sl == 1) ? sel0 : (sl == 2) ? sel1 : sel2;
#pragma unroll
            for (int kk = 0; kk < 4; ++kk) {
                const int key = lane + 64 * kk; float l = -3.0e38f;
                if (blk >= 0 && (sl > 0 || blk * KB + key <= s)) {
                    const bf16* kr = K + (size_t)(b * S_ + blk * KB + key) * DC + h * HD; float a = 0.f;
#pragma unroll
                    for (int d8 = 0; d8 < 8; ++d8) { float kf[8]; unpack8(*(const u32x4*)(kr + d8 * 8), kf);
#pragma unroll
                        for (int e = 0; e < 8; ++e) a += qs[d8 * 8 + e] * kf[e]; }
                    l = a; }
                lg[sl][kk] = l; mx = fmaxf(mx, l);
            }
        }
        mx = wave_max(mx);
        float sum = 0.f;
#pragma unroll
        for (int sl = 0; sl < 4; ++sl)
#pragma unroll
            for (int kk = 0; kk < 4; ++kk) { const float p = (lg[sl][kk] > -1.0e38f) ? exp2f(lg[sl][kk] - mx) : 0.f; sum += p; ps[sl * 256 + lane + 64 * kk] = bf2f(f2bf(p)); }
        sum = wave_sum(sum);
        __builtin_amdgcn_s_waitcnt(0); __builtin_amdgcn_wave_barrier();
        float o = 0.f;
#pragma unroll
        for (int sl = 0; sl < 4; ++sl) {
            const int blk = (sl == 0) ? qb : (sl == 1) ? sel0 : (sl == 2) ? sel1 : sel2;
            if (blk < 0) continue;
            const int nk = (sl == 0) ? (s - qb * KB + 1) : KB;
            const bf16* vr = V + (size_t)(b * S_ + blk * KB) * DC + h * HD + lane;
            for (int key = 0; key < nk; ++key) o += ps[sl * 256 + key] * bf2f(vr[(size_t)key * DC]);
        }
        const float y = o / sum * bf2f(SGA[(size_t)t * DC + h * HD + lane]);
        Y[(size_t)t * D_ + DC + h * HD + lane] = (bf16)f2bf(y);
        __builtin_amdgcn_s_waitcnt(0); __builtin_amdgcn_wave_barrier();
    }
}

__device__ __forceinline__ void p6_final(Frame& F) {
    const int gw = F.vcu * 8 + F.wave, NGW = F.G * 8;
    f32x4 g[4];
#pragma unroll
    for (int j = 0; j < 4; ++j) g[j] = *((const f32x4*)F.g_final + F.lane + 64 * j);
    for (int r = gw; r < T_; r += NGW) {
        f32x4* xr = (f32x4*)(F.out + (size_t)r * D_) + F.lane;
        f32x4 v[4]; float s = 0.f;
#pragma unroll
        for (int j = 0; j < 4; ++j) { v[j] = xr[64 * j]; s += (v[j].x * v[j].x + v[j].y * v[j].y) + (v[j].z * v[j].z + v[j].w * v[j].w); }
        const float rstd = rsqrtf(wave_sum(s) * (1.f / D_) + EPS_);
#pragma unroll
        for (int j = 0; j < 4; ++j) xr[64 * j] = v[j] * rstd * g[j];
    }
}

struct Args { const void* in[15]; float* out; unsigned char* ws; int ph_lo, ph_hi; };
constexpr int NPH = 9;

__global__ void __launch_bounds__(512, 2) mk_fwd(Args args) {
    extern __shared__ __attribute__((aligned(16))) unsigned char lds[];
    Frame F;
    F.lds = lds; F.tid = threadIdx.x; F.lane = F.tid & 63; F.wave = __builtin_amdgcn_readfirstlane(F.tid >> 6);
    F.G = gridDim.x; { const int bx = blockIdx.x; F.vcu = (F.G % 8 == 0) ? (bx % 8) * (F.G / 8) + bx / 8 : bx; }
    F.x = (const float*)args.in[0]; F.c = (const float*)args.in[1]; F.pos = (const int*)args.in[2]; F.w_ada = (const float*)args.in[3]; F.b_ada = (const float*)args.in[4];
    F.g_norm = (const float*)args.in[5]; F.w_in = (const float*)args.in[6]; F.w_dw = (const float*)args.in[7]; F.b_dw = (const float*)args.in[8];
    F.g_ln = (const float*)args.in[9]; F.b_ln = (const float*)args.in[10]; F.w_pw = (const float*)args.in[11]; F.b_pw = (const float*)args.in[12];
    F.w_out = (const float*)args.in[13]; F.g_final = (const float*)args.in[14];
    F.out = args.out; F.ws = args.ws;
    const int lo = args.ph_lo, hi = args.ph_hi;
#define IN(k) (lo <= (k) && (k) < hi)
#define SEAM(k) do { if (IN(k) && IN((k) + 1)) cg::this_grid().sync(); } while (0)
    if (IN(0)) { p0_mod(F); p0_rope(F); }
    SEAM(0);
    if (IN(1)) p1_h(F);
    SEAM(1);
    if (IN(2)) { EpiStoreBf16 E{(bf16*)(F.ws + WS_P), DIN}; naive_gemm(F, (const bf16*)(F.ws + WS_H), D_, F.w_in, T_, DIN, D_, E); }
    SEAM(2);
    if (IN(3)) n2_transform(F);
    SEAM(3);
    if (IN(4)) n2_kmean(F);
    SEAM(4);
    if (IN(5)) { n3_conv(F); n3_attn(F); }
    SEAM(5);
    if (IN(6)) { EpiPwNaive E{(bf16*)(F.ws + WS_YCAT), (const bf16*)(F.ws + WS_SGC), F.b_pw}; naive_gemm(F, (const bf16*)(F.ws + WS_ALN), DC, F.w_pw, T_, DC, DC, E); }
    SEAM(6);
    if (IN(7)) { EpiOutNaive E{F.out, F.x, (const float*)(F.ws + WS_MODP), F.b_ada}; naive_gemm(F, (const bf16*)(F.ws + WS_YCAT), D_, F.w_out, T_, D_, D_, E); }
    SEAM(7);
    if (IN(8)) p6_final(F);
#undef IN
#undef SEAM
}

extern "C" void kernel_launch(void* const* d_in, const int* in_sizes, int n_in, void* d_out, int out_size, void* d_ws, size_t ws_size, hipStream_t stream) {
    static int grid = 0;
    if (grid == 0) {
        if (n_in != 15 || out_size != T_ * D_ || ws_size < WS_END) { fprintf(stderr, "kernel_launch: unexpected problem (n_in %d out %d ws %zu)\n", n_in, out_size, ws_size); grid = -1; return; }
        int dev = 0, cus = 0, per_cu = 0;
        hipGetDevice(&dev); hipDeviceGetAttribute(&cus, hipDeviceAttributeMultiprocessorCount, dev);
        hipFuncSetAttribute((const void*)mk_fwd, hipFuncAttributeMaxDynamicSharedMemorySize, LDS_BYTES);
        hipOccupancyMaxActiveBlocksPerMultiprocessor(&per_cu, (const void*)mk_fwd, 512, LDS_BYTES);
        if (per_cu < 1) per_cu = 1;
        (void)hipGetLastError();
        grid = cus * per_cu;
    }
    if (grid < 0) return;
    hipMemsetAsync((char*)d_ws + WS_CTL, 0, CTL_ZERO, stream);
    Args a{};
    for (int i = 0; i < 15; ++i) a.in[i] = d_in[i];
    a.out = (float*)d_out; a.ws = (unsigned char*)d_ws;
    a.ph_lo = 0; a.ph_hi = NPH;
    void* kargs[] = {&a};
    hipError_t e = hipLaunchCooperativeKernel((const void*)mk_fwd, dim3(grid), dim3(512), kargs, LDS_BYTES, stream);
    if (e != hipSuccess) fprintf(stderr, "cooperative launch failed: %s (grid %d)\n", hipGetErrorString(e), grid);
}
```

```cpp
#include <hip/hip_runtime.h>
#include <hip/hip_cooperative_groups.h>
#include <cstdio>
#include <cstdint>
namespace cg = cooperative_groups;

constexpr int NB_ = 8, S_ = 4096, T_ = NB_ * S_, D_ = 1024, DIN = 3584, DC = 512, NH = 8, HD = 64, KB = 256, NKB = S_ / KB, CW = 31;
constexpr float EPS_ = 1e-6f;
constexpr float C2 = 0.125f * 1.4426950408889634f;

typedef unsigned short bf16;
typedef unsigned u32x4 __attribute__((ext_vector_type(4)));
typedef float f32x4 __attribute__((ext_vector_type(4)));

constexpr size_t MiB = 1u << 20;
constexpr size_t WS_CTL = 0;
constexpr size_t CTL_ZERO = 2 * MiB;
constexpr size_t WS_KMEAN = 1 * MiB;
constexpr size_t WS_MODP = 2 * MiB;
constexpr size_t WS_MOD = 2 * MiB + 512 * 1024;
constexpr size_t WS_ROPE = 3 * MiB;
constexpr size_t WS_WIN = 6 * MiB;
constexpr size_t WS_WPW = 13 * MiB;
constexpr size_t WS_WOUT = 14 * MiB;
constexpr size_t WS_H = 16 * MiB;
constexpr size_t WS_U = 80 * MiB;
constexpr size_t WS_SGC = 112 * MiB;
constexpr size_t WS_Q = 144 * MiB;
constexpr size_t WS_K = 176 * MiB;
constexpr size_t WS_V = 208 * MiB;
constexpr size_t WS_SGA = 240 * MiB;
constexpr size_t WS_ALN = 272 * MiB;
constexpr size_t WS_YCAT = 304 * MiB;
constexpr size_t WS_P = 272 * MiB;
constexpr size_t WS_END = 496 * MiB;

constexpr int LDS_BYTES = 147456;

__device__ __forceinline__ float bf2f(unsigned b) { return __uint_as_float(b << 16); }
__device__ __forceinline__ unsigned f2bf(float f) { unsigned u = __float_as_uint(f); return (u + 0x7fffu + ((u >> 16) & 1u)) >> 16; }
__device__ __forceinline__ unsigned pk2(float lo, float hi) { return f2bf(lo) | (f2bf(hi) << 16); }
__device__ __forceinline__ float silu_f(float v) { return v / (1.f + __expf(-v)); }
__device__ __forceinline__ float sigm_f(float v) { return 1.f / (1.f + __expf(-v)); }
__device__ __forceinline__ float wave_sum(float v) {
#pragma unroll
    for (int o = 1; o < 64; o <<= 1) v += __shfl_xor(v, o);
    return v;
}
__device__ __forceinline__ float wave_max(float v) {
#pragma unroll
    for (int o = 1; o < 64; o <<= 1) v = fmaxf(v, __shfl_xor(v, o));
    return v;
}
__device__ __forceinline__ void unpack8(const u32x4 v, float (&f)[8]) {
    f[0] = bf2f(v.x & 0xffffu); f[1] = bf2f(v.x >> 16); f[2] = bf2f(v.y & 0xffffu); f[3] = bf2f(v.y >> 16);
    f[4] = bf2f(v.z & 0xffffu); f[5] = bf2f(v.z >> 16); f[6] = bf2f(v.w & 0xffffu); f[7] = bf2f(v.w >> 16);
}
__device__ __forceinline__ u32x4 pack8(const float (&f)[8]) {
    u32x4 o; o.x = pk2(f[0], f[1]); o.y = pk2(f[2], f[3]); o.z = pk2(f[4], f[5]); o.w = pk2(f[6], f[7]); return o;
}

struct Frame {
    unsigned char* lds;
    int tid, lane, wave, vcu, G;
    const float *x, *c, *w_ada, *b_ada, *g_norm, *w_in, *w_dw, *b_dw, *g_ln, *b_ln, *w_pw, *b_pw, *w_out, *g_final;
    const int* pos;
    float* out; unsigned char* ws;
};

namespace pg8 {
#define PG8_LAS __attribute__((address_space(3)))
typedef unsigned short bf16_t;
typedef short bf16x8 __attribute__((ext_vector_type(8)));
typedef float f32x4 __attribute__((ext_vector_type(4)));
typedef unsigned u32x4 __attribute__((ext_vector_type(4)));
constexpr int BM = 256, BK = 64, HALF = 128, HTB = HALF * BK * 2  , STAGE_BYTES = 8 * HTB, NXCD = 8, WGM = 8;

__host__ __device__ __forceinline__ int lds_byte(int r, int c) { const int st = (r >> 4) * 2 + (c >> 5), rr = r & 15, cc = c & 31, ob = rr * 64 + cc * 2; return st * 1024 + (ob ^ (((ob >> 9) & 1) << 5)); }
__host__ __device__ __forceinline__ void stage_rc(int b, int& R, int& C) { const int st = b / 1024, sb = b % 1024, swz = sb ^ (((sb >> 9) & 1) << 5); R = (st >> 1) * 16 + swz / 64; C = (st & 1) * 32 + (swz % 64) / 2; }
__host__ __device__ __forceinline__ int perm32(int rho) { const int n = rho >> 4, i = rho & 15; return 8 * (i >> 2) + 4 * n + (i & 3); }

struct Unit { int pm, pn; };
struct Gemm { const bf16_t* A; const bf16_t* Bt; int M, N, K; };

struct StaticOrder {
    int nM, nN, nwg, G, c;
    __host__ __device__ void init(int M, int N, int G_, int c_) { nM = M / BM; nN = N / BM; nwg = nM * nN; G = G_; c = c_; }
    __host__ __device__ bool next(int i, Unit& u) const {
        const long L = (long)i * G + c; if (L >= nwg) return false;
        int wgid = (int)L; { const int q = nwg / NXCD, r = nwg % NXCD, xcd = wgid % NXCD, off = wgid / NXCD; wgid = (xcd < r ? xcd * (q + 1) : r * (q + 1) + (xcd - r) * q) + off; }
        const int nig = WGM * nN, gid = wgid / nig, fm = gid * WGM, gsz = (nM - fm) < WGM ? (nM - fm) : WGM;
        u.pm = fm + ((wgid % nig) % gsz); u.pn = (wgid % nig) / gsz; return true;
    }
    __device__ __forceinline__ void a_ready(const Unit&) const {}
    __device__ __forceinline__ void done(const Unit&) const {}
};

__device__ __forceinline__ unsigned cvt_pk_bf16(float lo, float hi) { unsigned r; asm volatile("v_cvt_pk_bf16_f32 %0, %1, %2" : "=v"(r) : "v"(lo), "v"(hi)); return r; }
typedef float f32x2 __attribute__((ext_vector_type(2)));
template <class Epi, class Sched, bool ALIGN_EPI = false, bool SP2 = false>
__device__ __forceinline__ void gemm_phase(PG8_LAS unsigned char* lds, const Gemm g, const Sched& S, const Epi& E) {
    const int tid = threadIdx.x, wid = __builtin_amdgcn_readfirstlane(tid >> 6), lane = tid & 63, wr = wid >> 2, wc = wid & 3, fr = lane & 15, fq = lane >> 4;
    const int K = g.K, nt = K / BK;
    unsigned voffA[2], voffB[2];
#pragma unroll
    for (int i = 0; i < 2; ++i) { int R, C; stage_rc(tid * 16 + i * 8192, R, C); const int Rb = Epi::PERM ? ((R & ~31) + perm32(R & 31)) : R;
        voffA[i] = (unsigned)(R * K + C) * 2u; voffB[i] = (unsigned)(Rb * K + C) * 2u; }
    const size_t kstep = (size_t)(BK * 2);
    const size_t hstep = (size_t)HALF * K * 2;
    const size_t tstep = 2 * hstep;
    const unsigned ldsw = (unsigned)wid * 1024u;
    const int aoff = lds_byte(wr * 64 + fr, fq * 8), boff = lds_byte(wc * 32 + fr, fq * 8);
#define PG8_SA(b, h) (((b) * 2 + (h)) * HTB)
#define PG8_SB(b, h) ((4 + (b) * 2 + (h)) * HTB)
#define PG8_STAGE(bufoff, gbase, voff) do { _Pragma("unroll") for (int _i = 0; _i < 2; ++_i) \
        __builtin_amdgcn_global_load_lds((const unsigned*)((const char*)(gbase) + (voff)[_i]), (PG8_LAS unsigned*)(lds + (bufoff) + ldsw + _i * 8192), 16, 0, 0); } while (0)
#define PG8_LDA(dst, b, h) do { _Pragma("unroll") for (int m = 0; m < 4; ++m) _Pragma("unroll") for (int k = 0; k < 2; ++k) dst[m][k] = *(const PG8_LAS bf16x8*)(lds + PG8_SA(b, h) + aoff + m * 2048 + k * 1024); } while (0)
#define PG8_LDB(dst, b, h) do { _Pragma("unroll") for (int n = 0; n < 2; ++n) _Pragma("unroll") for (int k = 0; k < 2; ++k) dst[n][k] = *(const PG8_LAS bf16x8*)(lds + PG8_SB(b, h) + boff + n * 2048 + k * 1024); } while (0)
#define PG8_MMA(ai, bj, At, Bt) do { __builtin_amdgcn_s_setprio(1); _Pragma("unroll") for (int m = 0; m < 4; ++m) _Pragma("unroll") for (int n = 0; n < 2; ++n) _Pragma("unroll") for (int k = 0; k < 2; ++k) \
        acc[ai][bj][m][n] = __builtin_amdgcn_mfma_f32_16x16x32_bf16(Bt[n][k], At[m][k], acc[ai][bj][m][n], 0, 0, 0); __builtin_amdgcn_s_setprio(0); } while (0)
#define PG8_WAIT_V(n) asm volatile("s_waitcnt vmcnt(" #n ")" ::: "memory")
#define PG8_WAIT_L(n) asm volatile("s_waitcnt lgkmcnt(" #n ")" ::: "memory")
#define PG8_BAR __builtin_amdgcn_s_barrier()
#define PG8_SCHED __builtin_amdgcn_sched_barrier(0)
    Unit cur, nxt; int ui = 0;
    if (!S.next(0, cur)) return;
    f32x4 acc[2][2][4][2];
#pragma unroll
    for (int a = 0; a < 2; ++a)
#pragma unroll
        for (int b = 0; b < 2; ++b)
#pragma unroll
            for (int m = 0; m < 4; ++m)
#pragma unroll
                for (int n = 0; n < 2; ++n) acc[a][b][m][n] = (f32x4){0.f, 0.f, 0.f, 0.f};
    bf16x8 At[4][2], B0[2][2], B1[2][2];
    const char* cA = (const char*)g.A + (size_t)cur.pm * tstep; const char* cB = (const char*)g.Bt + (size_t)cur.pn * tstep;
    S.a_ready(cur);
    if constexpr (SP2) {
        PG8_STAGE(PG8_SB(0, 0), cB, voffB); PG8_STAGE(PG8_SB(0, 1), cB + hstep, voffB); PG8_STAGE(PG8_SA(0, 0), cA, voffA); PG8_STAGE(PG8_SA(0, 1), cA + hstep, voffA);
        if (wr == 1) PG8_BAR;
        PG8_WAIT_V(2); PG8_BAR;
        PG8_STAGE(PG8_SB(1, 0), cB + kstep, voffB); PG8_STAGE(PG8_SA(1, 0), cA + kstep, voffA); PG8_STAGE(PG8_SB(1, 1), cB + hstep + kstep, voffB);
        PG8_WAIT_V(6); PG8_BAR;
    } else {
        PG8_STAGE(PG8_SB(0, 0), cB, voffB); PG8_STAGE(PG8_SA(0, 0), cA, voffA); PG8_STAGE(PG8_SB(0, 1), cB + hstep, voffB); PG8_STAGE(PG8_SA(0, 1), cA + hstep, voffA);
        if (wr == 1) PG8_BAR;
        PG8_WAIT_V(4); PG8_BAR;
        PG8_STAGE(PG8_SB(1, 0), cB + kstep, voffB); PG8_STAGE(PG8_SA(1, 0), cA + kstep, voffA); PG8_STAGE(PG8_SB(1, 1), cB + hstep + kstep, voffB);
        PG8_WAIT_V(6); PG8_BAR;
    }
    for (;;) {
        const bool has_next = S.next(ui + 1, nxt);
        const char* nA = has_next ? (const char*)g.A + (size_t)nxt.pm * tstep : cA; const char* nB = has_next ? (const char*)g.Bt + (size_t)nxt.pn * tstep : cB;
        for (int t = 0; t < nt; t += 2) {
            const bool last = (t == nt - 2);
            const char* a1 = cA + (size_t)(t + 1) * kstep;
            const char* a2 = last ? nA : cA + (size_t)(t + 2) * kstep; const char* b2 = last ? nB : cB + (size_t)(t + 2) * kstep;
            const char* a3 = a2 + kstep; const char* b3 = b2 + kstep;
            if (last && has_next) S.a_ready(nxt);
            if constexpr (SP2) {
            PG8_LDB(B0, 0, 0); PG8_LDB(B1, 0, 1); PG8_SCHED; PG8_LDA(At, 0, 0); PG8_STAGE(PG8_SA(1, 1), a1 + hstep, voffA);
            PG8_WAIT_V(8); PG8_WAIT_L(0); PG8_BAR; PG8_MMA(0, 0, At, B0); PG8_MMA(0, 1, At, B1); PG8_BAR; PG8_SCHED;
            PG8_LDA(At, 0, 1); PG8_STAGE(PG8_SB(0, 0), b2, voffB); PG8_STAGE(PG8_SB(0, 1), b2 + hstep, voffB); PG8_STAGE(PG8_SA(0, 0), a2, voffA);
            PG8_WAIT_V(8); PG8_WAIT_L(0); PG8_BAR; PG8_MMA(1, 0, At, B0); PG8_MMA(1, 1, At, B1); PG8_BAR; PG8_SCHED;
            PG8_LDB(B0, 1, 0); PG8_LDB(B1, 1, 1); PG8_SCHED; PG8_LDA(At, 1, 0); PG8_STAGE(PG8_SA(0, 1), a2 + hstep, voffA);
            PG8_WAIT_V(8); PG8_WAIT_L(0); PG8_BAR; PG8_MMA(0, 0, At, B0); PG8_MMA(0, 1, At, B1); PG8_BAR; PG8_SCHED;
            PG8_LDA(At, 1, 1); PG8_STAGE(PG8_SB(1, 0), b3, voffB); PG8_STAGE(PG8_SB(1, 1), b3 + hstep, voffB); PG8_STAGE(PG8_SA(1, 0), a3, voffA);
            PG8_WAIT_V(8); PG8_WAIT_L(0); PG8_BAR; PG8_MMA(1, 0, At, B0); PG8_MMA(1, 1, At, B1); PG8_BAR; PG8_SCHED;
            } else {
            PG8_LDB(B0, 0, 0); PG8_SCHED; PG8_LDA(At, 0, 0); PG8_STAGE(PG8_SA(1, 1), a1 + hstep, voffA);
            PG8_WAIT_L(8); PG8_BAR; PG8_WAIT_L(0); PG8_MMA(0, 0, At, B0); PG8_BAR; PG8_SCHED;
            PG8_LDB(B1, 0, 1); PG8_STAGE(PG8_SB(0, 0), b2, voffB);
            PG8_BAR; PG8_WAIT_L(0); PG8_MMA(0, 1, At, B1); PG8_BAR;
            PG8_LDA(At, 0, 1); PG8_STAGE(PG8_SA(0, 0), a2, voffA);
            PG8_BAR; PG8_WAIT_L(0); PG8_MMA(1, 0, At, B0); PG8_BAR; PG8_SCHED;
            PG8_STAGE(PG8_SB(0, 1), b2 + hstep, voffB);
            PG8_WAIT_V(6); PG8_BAR; PG8_MMA(1, 1, At, B1); PG8_BAR;
            PG8_LDB(B0, 1, 0); PG8_SCHED; PG8_LDA(At, 1, 0); PG8_STAGE(PG8_SA(0, 1), a2 + hstep, voffA);
            PG8_WAIT_L(8); PG8_BAR; PG8_WAIT_L(0); PG8_MMA(0, 0, At, B0); PG8_BAR; PG8_SCHED;
            PG8_LDB(B1, 1, 1); PG8_STAGE(PG8_SB(1, 0), b3, voffB);
            PG8_BAR; PG8_WAIT_L(0); PG8_MMA(0, 1, At, B1); PG8_BAR;
            PG8_LDA(At, 1, 1); PG8_STAGE(PG8_SA(1, 0), a3, voffA);
            PG8_BAR; PG8_WAIT_L(0); PG8_MMA(1, 0, At, B0); PG8_BAR; PG8_SCHED;
            PG8_STAGE(PG8_SB(1, 1), b3 + hstep, voffB);
            PG8_WAIT_V(6); PG8_BAR; PG8_MMA(1, 1, At, B1); PG8_BAR;
            }
        }
        if constexpr (ALIGN_EPI) { if (wr == 0) PG8_BAR; }
        if constexpr (!Epi::AFTER_DRAIN) { E(acc, cur, wr, wc, fr, fq); S.done(cur); }
        if (!has_next) break;
#pragma unroll
        for (int a = 0; a < 2; ++a)
#pragma unroll
            for (int b = 0; b < 2; ++b)
#pragma unroll
                for (int m = 0; m < 4; ++m)
#pragma unroll
                    for (int n = 0; n < 2; ++n) acc[a][b][m][n] = (f32x4){0.f, 0.f, 0.f, 0.f};
        cur = nxt; cA = nA; cB = nB; ++ui;
        if constexpr (ALIGN_EPI) { if (wr == 1) PG8_BAR; }
    }
    PG8_WAIT_V(0);
    if constexpr (!ALIGN_EPI) { if (wr == 0) PG8_BAR; }
    PG8_BAR;
    if constexpr (Epi::AFTER_DRAIN) { E.fused(acc, cur, wr, wc, fr, fq, lds, wid, lane); S.done(cur); }
#undef PG8_SA
#undef PG8_SB
#undef PG8_STAGE
#undef PG8_LDA
#undef PG8_LDB
#undef PG8_MMA
#undef PG8_WAIT_V
#undef PG8_WAIT_L
#undef PG8_BAR
#undef PG8_SCHED
}
}

__device__ __forceinline__ int colmap_in(int n) {
    const int tile = n >> 8, w = n & 255;
    if (tile < 4) return ((w >> 7) ? 512 : 0) + tile * 128 + (w & 127);
    if (tile >= 6 && tile < 10) { const int vd = n & 63; if (vd < 16) { const int g = vd >> 3, e = vd & 7; return (n & ~63) + ((e < 4) ? 4 * g + e : 8 + 4 * g + (e - 4)); } }
    return n;
}
__device__ __forceinline__ u32x4 pack2v(const f32x4 a, const f32x4 b) { u32x4 w; w.x = pg8::cvt_pk_bf16(a[0], a[1]); w.y = pg8::cvt_pk_bf16(a[2], a[3]); w.z = pg8::cvt_pk_bf16(b[0], b[1]); w.w = pg8::cvt_pk_bf16(b[2], b[3]); return w; }
__device__ __forceinline__ f32x4 sigm4(const f32x4 g) { f32x4 r; r.x = sigm_f(g.x); r.y = sigm_f(g.y); r.z = sigm_f(g.z); r.w = sigm_f(g.w); return r; }
struct EpiProj {
    static constexpr bool PERM = true, AFTER_DRAIN = false;
    bf16 *U, *SGC, *Q, *K, *V, *SGA; const float* ROPE; float* KM;
    __device__ __forceinline__ void operator()(const f32x4 (&acc)[2][2][4][2], const pg8::Unit& u, int wr, int wc, int fr, int fq) const {
        const int row0 = u.pm * 256 + wr * 64 + fr, colw = wc * 32 + 8 * fq, pn = u.pn;
        if (pn < 4) {
#pragma unroll
            for (int ai = 0; ai < 2; ++ai)
#pragma unroll
                for (int m = 0; m < 4; ++m) { const int row = row0 + ai * 128 + m * 16;
                    const f32x4 o0 = acc[ai][0][m][0] * sigm4(acc[ai][1][m][0]), o1 = acc[ai][0][m][1] * sigm4(acc[ai][1][m][1]);
                    *(u32x4*)(U + (size_t)row * DC + pn * 128 + colw) = pack2v(o0, o1); }
            return;
        }
        const int sec = (pn - 4) >> 1, cb = ((pn - 4) & 1) * 256;
        bf16* base = (sec == 0) ? SGC : (sec == 1) ? Q : (sec == 2) ? K : (sec == 3) ? V : SGA;
        const bool is_qk = (sec == 1 || sec == 2), rope_w = is_qk && !(wc & 1), rope_l = rope_w && fq < 2;
        f32x4 ks[2][2];
#pragma unroll
        for (int bj = 0; bj < 2; ++bj) { ks[bj][0] = (f32x4){0.f, 0.f, 0.f, 0.f}; ks[bj][1] = (f32x4){0.f, 0.f, 0.f, 0.f}; }
#pragma unroll
        for (int ai = 0; ai < 2; ++ai)
#pragma unroll
            for (int m = 0; m < 4; ++m) { const int row = row0 + ai * 128 + m * 16;
                f32x4 cs0 = (f32x4){1.f, 0.f, 1.f, 0.f}, cs1 = cs0;
                if (rope_w) { const f32x4* rp = (const f32x4*)(ROPE + ((size_t)row * 8 + 4 * (fq & 1)) * 2); cs0 = rp[0]; cs1 = rp[1]; }
#pragma unroll
                for (int bj = 0; bj < 2; ++bj) { f32x4 v0 = acc[ai][bj][m][0], v1 = acc[ai][bj][m][1];
                    if (sec == 0 || sec == 4) { v0 = v0 * sigm4(v0); v1 = v1 * sigm4(v1); }
                    else if (is_qk) {
                        if (rope_w) { const f32x4 co = (f32x4){cs0.x, cs0.z, cs1.x, cs1.z}, si = (f32x4){cs0.y, cs0.w, cs1.y, cs1.w};
                            const f32x4 r1 = v0 * co - v1 * si, r2 = v1 * co + v0 * si;
                            if (rope_l) { v0 = r1; v1 = r2; } }
                        if (sec == 1) { v0 = v0 * C2; v1 = v1 * C2; } else { ks[bj][0] += v0; ks[bj][1] += v1; }
                    }
                    *(u32x4*)(base + (size_t)row * DC + cb + bj * 128 + colw) = pack2v(v0, v1); } }
        if (sec == 2) {
            const int b = u.pm >> 4, blk = u.pm & 15;
#pragma unroll
            for (int bj = 0; bj < 2; ++bj)
#pragma unroll
                for (int n = 0; n < 2; ++n)
#pragma unroll
                    for (int e = 0; e < 4; ++e) { float s = ks[bj][n][e];
                        s += __shfl_xor(s, 1); s += __shfl_xor(s, 2); s += __shfl_xor(s, 4); s += __shfl_xor(s, 8);
                        if (fr == 0) { const int kc = cb + bj * 128 + colw + 4 * n + e; atomicAdd(KM + (((size_t)b * NH + (kc >> 6)) * NKB + blk) * HD + (kc & 63), s * (1.f / KB)); } }
        }
    }
};
struct EpiPw {
    static constexpr bool PERM = true, AFTER_DRAIN = false;
    bf16* Y; const bf16* SGC; const float* bias;
    __device__ __forceinline__ void operator()(const f32x4 (&acc)[2][2][4][2], const pg8::Unit& u, int wr, int wc, int fr, int fq) const {
        const int row0 = u.pm * 256 + wr * 64 + fr, col0 = u.pn * 256 + wc * 32 + 8 * fq;
        f32x4 bv[2][2];
#pragma unroll
        for (int bj = 0; bj < 2; ++bj) { bv[bj][0] = *(const f32x4*)(bias + col0 + bj * 128); bv[bj][1] = *(const f32x4*)(bias + col0 + bj * 128 + 4); }
#pragma unroll
        for (int ai = 0; ai < 2; ++ai)
#pragma unroll
            for (int m = 0; m < 4; ++m) { const int row = row0 + ai * 128 + m * 16;
#pragma unroll
                for (int bj = 0; bj < 2; ++bj) { float g[8]; unpack8(*(const u32x4*)(SGC + (size_t)row * DC + col0 + bj * 128), g);
                    const f32x4 v0 = (acc[ai][bj][m][0] + bv[bj][0]) * (f32x4){g[0], g[1], g[2], g[3]}, v1 = (acc[ai][bj][m][1] + bv[bj][1]) * (f32x4){g[4], g[5], g[6], g[7]};
                    *(u32x4*)(Y + (size_t)row * D_ + col0 + bj * 128) = pack2v(v0, v1); } }
    }
};
struct EpiOut {
    static constexpr bool PERM = false, AFTER_DRAIN = false;
    float* O; const float* x; const float* MOD;
    __device__ __forceinline__ void operator()(const f32x4 (&acc)[2][2][4][2], const pg8::Unit& u, int wr, int wc, int fr, int fq) const {
        const int row0 = u.pm * 256 + wr * 64 + fr, col0 = u.pn * 256 + wc * 32 + 4 * fq, b = u.pm >> 4;
        f32x4 gv[2][2];
#pragma unroll
        for (int bj = 0; bj < 2; ++bj)
#pragma unroll
            for (int n = 0; n < 2; ++n) gv[bj][n] = *(const f32x4*)(MOD + (size_t)b * 3072 + 2048 + col0 + bj * 128 + n * 16);
#pragma unroll
        for (int ai = 0; ai < 2; ++ai)
#pragma unroll
            for (int m = 0; m < 4; ++m) { const size_t off = (size_t)(row0 + ai * 128 + m * 16) * D_ + col0;
#pragma unroll
                for (int bj = 0; bj < 2; ++bj)
#pragma unroll
                    for (int n = 0; n < 2; ++n) { const f32x4 xv = *(const f32x4*)(x + off + bj * 128 + n * 16);
                        *(f32x4*)(O + off + bj * 128 + n * 16) = xv + gv[bj][n] * acc[ai][bj][m][n]; } }
    }
};

template <bool MAP>
__device__ __forceinline__ void p0_transpose_item(const float* W, int K, int N, bf16* WT, float* scr, int item, int lane) {
    const int nblk = N / 32, kb = item / nblk, nb = item % nblk, k0 = 64 * kb, n0 = 32 * nb;
    const int ncol = MAP ? colmap_in(n0 + (lane & 31)) : n0 + (lane & 31);
#pragma unroll 8
    for (int i = 0; i < 32; ++i) { const int kk = 2 * i + (lane >> 5); scr[kk * 33 + (lane & 31)] = W[(size_t)(k0 + kk) * N + ncol]; }
    __builtin_amdgcn_s_waitcnt(0); __builtin_amdgcn_wave_barrier();
    const int c = lane & 7;
#pragma unroll
    for (int j = 0; j < 4; ++j) { const int n = (lane >> 3) + 8 * j; const float* s = scr + (8 * c) * 33 + n;
        u32x4 o; o.x = pk2(s[0 * 33], s[1 * 33]); o.y = pk2(s[2 * 33], s[3 * 33]); o.z = pk2(s[4 * 33], s[5 * 33]); o.w = pk2(s[6 * 33], s[7 * 33]);
        *(u32x4*)(WT + (size_t)(n0 + n) * K + k0 + 8 * c) = o; }
    __builtin_amdgcn_s_waitcnt(0); __builtin_amdgcn_wave_barrier();
}

__device__ __forceinline__ void p0_mod(Frame& F) {
    float* red = (float*)F.lds;
    float* MODP = (float*)(F.ws + WS_MODP);
    for (int it = F.vcu; it < 48 * 4; it += F.G) {
        const int cc = it % 48, q = it / 48, n = cc * 64 + F.lane, k0 = q * 256 + F.wave * 32;
        float acc[8];
#pragma unroll
        for (int b = 0; b < 8; ++b) acc[b] = 0.f;
#pragma unroll 8
        for (int kk = 0; kk < 32; ++kk) {
            const float w = F.w_ada[(size_t)(k0 + kk) * 3072 + n];
#pragma unroll
            for (int b = 0; b < 8; ++b) { const float cv = F.c[b * D_ + k0 + kk]; acc[b] += silu_f(cv) * w; }
        }
        __syncthreads();
#pragma unroll
        for (int b = 0; b < 8; ++b) red[(F.wave * 8 + b) * 64 + F.lane] = acc[b];
        __syncthreads();
        {
            float s = 0.f;
#pragma unroll
            for (int w = 0; w < 8; ++w) s += red[(w * 8 + F.wave) * 64 + F.lane];
            MODP[((size_t)q * 8 + F.wave) * 3072 + n] = s;
        }
    }
    __syncthreads();
}
__device__ __forceinline__ void p0_rope(Frame& F) {
    float* ROPE = (float*)(F.ws + WS_ROPE);
    const int gt = F.vcu * 512 + F.tid, NT = F.G * 512;
    for (int e = gt; e < T_ * 8; e += NT) {
        const int t = e >> 3, i = e & 7;
        const double inv = (i == 0) ? 1.0 : (i == 1) ? 0.19392274474868576 : (i == 2) ? 0.03760603093086393 : (i == 3) ? 0.007292664737217109 :
                           (i == 4) ? 0.001414213562373095 : (i == 5) ? 0.0002742481756762073 : (i == 6) ? 5.318295896944988e-05 : 1.031338537721246e-05;
        const double rev = (double)F.pos[t] * inv * 0.15915494309189535;
        const float fr = (float)(rev - floor(rev));
        ROPE[2 * e] = __builtin_amdgcn_cosf(fr); ROPE[2 * e + 1] = __builtin_amdgcn_sinf(fr);
    }
}
__device__ __forceinline__ void p0_weights(Frame& F) {
    float* scr = (float*)(F.lds + 16384 + F.wave * 16384);
    const int gw = F.vcu * 8 + F.wave, NGW = F.G * 8;
    constexpr int I_IN = (D_ / 64) * (DIN / 32), I_PW = (DC / 64) * (DC / 32), I_OUT = (D_ / 64) * (D_ / 32);
    for (int it = gw; it < I_IN + I_PW + I_OUT; it += NGW) {
        int r = it;
        if (r < I_IN) { p0_transpose_item<true>(F.w_in, D_, DIN, (bf16*)(F.ws + WS_WIN), scr, r, F.lane); continue; } r -= I_IN;
        if (r < I_PW) { p0_transpose_item<false>(F.w_pw, DC, DC, (bf16*)(F.ws + WS_WPW), scr, r, F.lane); continue; } r -= I_PW;
        p0_transpose_item<false>(F.w_out, D_, D_, (bf16*)(F.ws + WS_WOUT), scr, r, F.lane);
    }
}
__device__ __forceinline__ float mod_at(Frame& F, int b, int n) {
    const float* MODP = (const float*)(F.ws + WS_MODP);
    float s = F.b_ada[n];
#pragma unroll
    for (int q = 0; q < 4; ++q) s += MODP[((size_t)q * 8 + b) * 3072 + n];
    return s;
}

__device__ __forceinline__ void p1_h(Frame& F) {
    bf16* Hb = (bf16*)(F.ws + WS_H);
    { float* MOD = (float*)(F.ws + WS_MOD); for (int e = F.vcu * 512 + F.tid; e < NB_ * 3072; e += F.G * 512) MOD[e] = mod_at(F, e / 3072, e % 3072); }
    const int gw = F.vcu * 8 + F.wave, NGW = F.G * 8, RPW = 16;
    for (int blk = gw; blk < T_ / RPW; blk += NGW) {
        const int r0 = blk * RPW, b = r0 / S_;
        f32x4 gs[4], sh[4];
#pragma unroll
        for (int j = 0; j < 4; ++j) {
            const int k = 4 * F.lane + 256 * j;
            float g4[4], s4[4];
#pragma unroll
            for (int e = 0; e < 4; ++e) { g4[e] = F.g_norm[k + e] * (1.f + mod_at(F, b, 1024 + k + e)); s4[e] = mod_at(F, b, k + e); }
            gs[j] = (f32x4){g4[0], g4[1], g4[2], g4[3]}; sh[j] = (f32x4){s4[0], s4[1], s4[2], s4[3]};
        }
        for (int r = r0; r < r0 + RPW; ++r) {
            const f32x4* xr = (const f32x4*)(F.x + (size_t)r * D_) + F.lane;
            f32x4 v[4]; float s = 0.f;
#pragma unroll
            for (int j = 0; j < 4; ++j) { v[j] = xr[64 * j]; s += (v[j].x * v[j].x + v[j].y * v[j].y) + (v[j].z * v[j].z + v[j].w * v[j].w); }
            const float rstd = rsqrtf(wave_sum(s) * (1.f / D_) + EPS_);
            unsigned long long* o8 = (unsigned long long*)(Hb + (size_t)r * D_) + F.lane;
#pragma unroll
            for (int j = 0; j < 4; ++j) { const f32x4 h = v[j] * rstd * gs[j] + sh[j];
                o8[64 * j] = (unsigned long long)pk2(h.x, h.y) | ((unsigned long long)pk2(h.z, h.w) << 32); }
        }
    }
}

template <class Epi>
__device__ __forceinline__ void naive_gemm(Frame& F, const bf16* A, int lda, const float* W, int M, int N, int K, const Epi& epi) {
    float* As = (float*)F.lds;
    float* Bs = As + 32 * 132;
    const int tid = F.tid, ty = tid >> 4, tx = tid & 15;
    const int ntn = N / 128, ntiles = (M / 128) * ntn;
    const int arow = tid >> 2, akq = (tid & 3) * 8, bkk = tid >> 4, bn8 = (tid & 15) * 8;
    for (int tile = F.vcu; tile < ntiles; tile += F.G) {
        const int tm = tile / ntn, tn = tile % ntn;
        float acc[4][8];
#pragma unroll
        for (int i = 0; i < 4; ++i)
#pragma unroll
            for (int j = 0; j < 8; ++j) acc[i][j] = 0.f;
        for (int k0 = 0; k0 < K; k0 += 32) {
            const u32x4 av = *(const u32x4*)(A + (size_t)(tm * 128 + arow) * lda + k0 + akq);
            const f32x4 b0 = *(const f32x4*)(W + (size_t)(k0 + bkk) * N + tn * 128 + bn8);
            const f32x4 b1 = *(const f32x4*)(W + (size_t)(k0 + bkk) * N + tn * 128 + bn8 + 4);
            __syncthreads();
            float af[8]; unpack8(av, af);
#pragma unroll
            for (int i = 0; i < 8; ++i) As[(akq + i) * 132 + arow] = af[i];
            *(f32x4*)&Bs[bkk * 132 + bn8] = b0; *(f32x4*)&Bs[bkk * 132 + bn8 + 4] = b1;
            __syncthreads();
#pragma unroll 8
            for (int kk = 0; kk < 32; ++kk) {
                const f32x4 a4 = *(const f32x4*)&As[kk * 132 + ty * 4];
                const f32x4 c0 = *(const f32x4*)&Bs[kk * 132 + tx * 8], c1 = *(const f32x4*)&Bs[kk * 132 + tx * 8 + 4];
                const float a[4] = {a4.x, a4.y, a4.z, a4.w}; const float bb[8] = {c0.x, c0.y, c0.z, c0.w, c1.x, c1.y, c1.z, c1.w};
#pragma unroll
                for (int i = 0; i < 4; ++i)
#pragma unroll
                    for (int j = 0; j < 8; ++j) acc[i][j] += a[i] * bb[j];
            }
        }
#pragma unroll
        for (int i = 0; i < 4; ++i) epi(tm * 128 + ty * 4 + i, tn * 128 + tx * 8, acc[i]);
    }
    __syncthreads();
}
struct EpiStoreBf16 { bf16* O; int ldc;
    __device__ __forceinline__ void operator()(int row, int col, const float (&v)[8]) const { *(u32x4*)(O + (size_t)row * ldc + col) = pack8(v); } };
struct EpiPwNaive { bf16* O; const bf16* SGC; const float* bias;
    __device__ __forceinline__ void operator()(int row, int col, const float (&v)[8]) const {
        float g[8], o[8]; unpack8(*(const u32x4*)(SGC + (size_t)row * DC + col), g);
#pragma unroll
        for (int j = 0; j < 8; ++j) o[j] = (v[j] + bias[col + j]) * g[j];
        *(u32x4*)(O + (size_t)row * D_ + col) = pack8(o); } };
struct EpiOutNaive { float* O; const float* x; const float* modp; const float* b_ada;
    __device__ __forceinline__ void operator()(int row, int col, const float (&v)[8]) const {
        const int b = row / S_;
#pragma unroll
        for (int j = 0; j < 8; ++j) { float g = b_ada[2048 + col + j];
#pragma unroll
            for (int q = 0; q < 4; ++q) g += modp[((size_t)q * 8 + b) * 3072 + 2048 + col + j];
            O[(size_t)row * D_ + col + j] = x[(size_t)row * D_ + col + j] + g * v[j]; } } };

__device__ __forceinline__ void n2_transform(Frame& F) {
    const bf16* P = (const bf16*)(F.ws + WS_P); const float* ROPE = (const float*)(F.ws + WS_ROPE);
    bf16 *U = (bf16*)(F.ws + WS_U), *SGC = (bf16*)(F.ws + WS_SGC), *Q = (bf16*)(F.ws + WS_Q), *K = (bf16*)(F.ws + WS_K), *V = (bf16*)(F.ws + WS_V), *SGA = (bf16*)(F.ws + WS_SGA);
    const int gw = F.vcu * 8 + F.wave, NGW = F.G * 8, c8 = F.lane * 8;
    for (int t = gw; t < T_; t += NGW) {
        const bf16* pr = P + (size_t)t * DIN;
        float a[8], g[8], o[8];
        unpack8(*(const u32x4*)(pr + c8), a); unpack8(*(const u32x4*)(pr + 512 + c8), g);
#pragma unroll
        for (int j = 0; j < 8; ++j) o[j] = a[j] * sigm_f(g[j]);
        *(u32x4*)(U + (size_t)t * DC + c8) = pack8(o);
        unpack8(*(const u32x4*)(pr + 1024 + c8), a);
#pragma unroll
        for (int j = 0; j < 8; ++j) o[j] = silu_f(a[j]);
        *(u32x4*)(SGC + (size_t)t * DC + c8) = pack8(o);
        float cs[8], sn[8];
#pragma unroll
        for (int j = 0; j < 8; ++j) { cs[j] = ROPE[((size_t)t * 8 + j) * 2]; sn[j] = ROPE[((size_t)t * 8 + j) * 2 + 1]; }
#pragma unroll
        for (int which = 0; which < 2; ++which) {
            unpack8(*(const u32x4*)(pr + (which ? 2048 : 1536) + c8), a);
            float p[8];
#pragma unroll
            for (int j = 0; j < 8; ++j) p[j] = __shfl_xor(a[j], 1);
            const int l7 = F.lane & 7;
#pragma unroll
            for (int j = 0; j < 8; ++j) { float r = a[j];
                if (l7 == 0) r = a[j] * cs[j] - p[j] * sn[j];
                else if (l7 == 1) r = a[j] * cs[j] + p[j] * sn[j];
                o[j] = which ? r : r * C2; }
            *(u32x4*)((which ? K : Q) + (size_t)t * DC + c8) = pack8(o);
        }
        *(u32x4*)(V + (size_t)t * DC + c8) = *(const u32x4*)(pr + 2560 + c8);
        unpack8(*(const u32x4*)(pr + 3072 + c8), a);
#pragma unroll
        for (int j = 0; j < 8; ++j) o[j] = silu_f(a[j]);
        *(u32x4*)(SGA + (size_t)t * DC + c8) = pack8(o);
    }
}
__device__ __forceinline__ void n2_kmean(Frame& F) {
    const bf16* K = (const bf16*)(F.ws + WS_K); float* KM = (float*)(F.ws + WS_KMEAN);
    const int gt = F.vcu * 512 + F.tid, NT = F.G * 512;
    for (int e = gt; e < NB_ * NKB * DC; e += NT) {
        const int col = e % DC, blk = (e / DC) % NKB, b = e / (DC * NKB);
        float s = 0.f;
        for (int r = 0; r < KB; ++r) s += bf2f(K[(size_t)(b * S_ + blk * KB + r) * DC + col]);
        KM[(((size_t)b * NH + col / HD) * NKB + blk) * HD + (col % HD)] = s * (1.f / KB);
    }
}

__device__ __forceinline__ void n3_conv(Frame& F) {
    const bf16* U = (const bf16*)(F.ws + WS_U); bf16* ALN = (bf16*)(F.ws + WS_ALN);
    const int gw = F.vcu * 8 + F.wave, NGW = F.G * 8, c8 = F.lane * 8;
    for (int t = gw; t < T_; t += NGW) {
        const int s = t % S_;
        float acc[8];
        { const f32x4 b0 = *(const f32x4*)(F.b_dw + c8), b1 = *(const f32x4*)(F.b_dw + c8 + 4);
          acc[0] = b0.x; acc[1] = b0.y; acc[2] = b0.z; acc[3] = b0.w; acc[4] = b1.x; acc[5] = b1.y; acc[6] = b1.z; acc[7] = b1.w; }
        for (int w = 0; w < CW; ++w) {
            const int sp = s - (CW - 1) + w;
            if (sp < 0) continue;
            float u[8]; unpack8(*(const u32x4*)(U + (size_t)(t - (CW - 1) + w) * DC + c8), u);
            const f32x4 k0 = *(const f32x4*)(F.w_dw + w * DC + c8), k1 = *(const f32x4*)(F.w_dw + w * DC + c8 + 4);
            acc[0] += u[0] * k0.x; acc[1] += u[1] * k0.y; acc[2] += u[2] * k0.z; acc[3] += u[3] * k0.w;
            acc[4] += u[4] * k1.x; acc[5] += u[5] * k1.y; acc[6] += u[6] * k1.z; acc[7] += u[7] * k1.w;
        }
        float sm = 0.f;
#pragma unroll
        for (int j = 0; j < 8; ++j) sm += acc[j];
        const float mu = wave_sum(sm) * (1.f / DC);
        float sq = 0.f;
#pragma unroll
        for (int j = 0; j < 8; ++j) { acc[j] -= mu; sq += acc[j] * acc[j]; }
        const float rstd = rsqrtf(wave_sum(sq) * (1.f / DC) + EPS_);
        float o[8];
#pragma unroll
        for (int j = 0; j < 8; ++j) o[j] = silu_f(acc[j] * rstd * F.g_ln[c8 + j] + F.b_ln[c8 + j]);
        *(u32x4*)(ALN + (size_t)t * DC + c8) = pack8(o);
    }
}

__device__ __forceinline__ void n3_attn(Frame& F) {
    const bf16 *Q = (const bf16*)(F.ws + WS_Q), *K = (const bf16*)(F.ws + WS_K), *V = (const bf16*)(F.ws + WS_V), *SGA = (const bf16*)(F.ws + WS_SGA);
    const float* KM = (const float*)(F.ws + WS_KMEAN); bf16* Y = (bf16*)(F.ws + WS_YCAT);
    float* qs = (float*)F.lds + F.wave * 64;
    float* ps = (float*)F.lds + 512 + F.wave * 1024;
    const int gw = F.vcu * 8 + F.wave, NGW = F.G * 8, lane = F.lane;
    for (int it = gw; it < T_ * NH; it += NGW) {
        const int h = it % NH, t = it / NH, b = t / S_, s = t % S_, qb = s / KB;
        const float qv = bf2f(Q[(size_t)t * DC + h * HD + lane]);
        qs[lane] = qv;
        __builtin_amdgcn_s_waitcnt(0); __builtin_amdgcn_wave_barrier();
        float gate = -3.0e38f;
        if (lane < qb) { const float* km = KM + (((size_t)b * NH + h) * NKB + lane) * HD; float g = 0.f;
            for (int d = 0; d < HD; ++d) g += qs[d] * km[d];
            gate = g; }
        int sel0 = -1, sel1 = -1, sel2 = -1;
        {
            float g0 = -3.0e38f, g1 = -3.0e38f, g2 = -3.0e38f;
            for (int j = 0; j < NKB; ++j) { const float gj = __shfl(gate, j);
                if (j < qb) {
                    if (gj > g0) { g2 = g1; sel2 = sel1; g1 = g0; sel1 = sel0; g0 = gj; sel0 = j; }
                    else if (gj > g1) { g2 = g1; sel2 = sel1; g1 = gj; sel1 = j; }
                    else if (gj > g2) { g2 = gj; sel2 = j; } } }
        }
        float lg[4][4]; float mx = -3.0e38f;
#pragma unroll
        for (int sl = 0; sl < 4; ++sl) {
            const int blk = (sl == 0) ? qb : (sl == 1) ? sel0 : (sl == 2) ? sel1 : sel2;
#pragma unroll
            for (int kk = 0; kk < 4; ++kk) {
                const int key = lane + 64 * kk; float l = -3.0e38f;
                if (blk >= 0 && (sl > 0 || blk * KB + key <= s)) {
                    const bf16* kr = K + (size_t)(b * S_ + blk * KB + key) * DC + h * HD; float a = 0.f;
#pragma unroll
                    for (int d8 = 0; d8 < 8; ++d8) { float kf[8]; unpack8(*(const u32x4*)(kr + d8 * 8), kf);
#pragma unroll
                        for (int e = 0; e < 8; ++e) a += qs[d8 * 8 + e] * kf[e]; }
                    l = a; }
                lg[sl][kk] = l; mx = fmaxf(mx, l);
            }
        }
        mx = wave_max(mx);
        float sum = 0.f;
#pragma unroll
        for (int sl = 0; sl < 4; ++sl)
#pragma unroll
            for (int kk = 0; kk < 4; ++kk) { const float p = (lg[sl][kk] > -1.0e38f) ? exp2f(lg[sl][kk] - mx) : 0.f; sum += p; ps[sl * 256 + lane + 64 * kk] = bf2f(f2bf(p)); }
        sum = wave_sum(sum);
        __builtin_amdgcn_s_waitcnt(0); __builtin_amdgcn_wave_barrier();
        float o = 0.f;
#pragma unroll
        for (int sl = 0; sl < 4; ++sl) {
            const int blk = (sl == 0) ? qb : (sl == 1) ? sel0 : (sl == 2) ? sel1 : sel2;
            if (blk < 0) continue;
            const int nk = (sl == 0) ? (s - qb * KB + 1) : KB;
            const bf16* vr = V + (size_t)(b * S_ + blk * KB) * DC + h * HD + lane;
            for (int key = 0; key < nk; ++key) o += ps[sl * 256 + key] * bf2f(vr[(size_t)key * DC]);
        }
        const float y = o / sum * bf2f(SGA[(size_t)t * DC + h * HD + lane]);
        Y[(size_t)t * D_ + DC + h * HD + lane] = (bf16)f2bf(y);
        __builtin_amdgcn_s_waitcnt(0); __builtin_amdgcn_wave_barrier();
    }
}

__device__ __forceinline__ void p6_final(Frame& F) {
    const int gw = F.vcu * 8 + F.wave, NGW = F.G * 8;
    f32x4 g[4];
#pragma unroll
    for (int j = 0; j < 4; ++j) g[j] = *((const f32x4*)F.g_final + F.lane + 64 * j);
    for (int r = gw; r < T_; r += NGW) {
        f32x4* xr = (f32x4*)(F.out + (size_t)r * D_) + F.lane;
        f32x4 v[4]; float s = 0.f;
#pragma unroll
        for (int j = 0; j < 4; ++j) { v[j] = xr[64 * j]; s += (v[j].x * v[j].x + v[j].y * v[j].y) + (v[j].z * v[j].z + v[j].w * v[j].w); }
        const float rstd = rsqrtf(wave_sum(s) * (1.f / D_) + EPS_);
#pragma unroll
        for (int j = 0; j < 4; ++j) xr[64 * j] = v[j] * rstd * g[j];
    }
}

struct Args { const void* in[15]; float* out; unsigned char* ws; int ph_lo, ph_hi; };
constexpr int NPH = 7;

__global__ void __launch_bounds__(512, 2) mk_fwd(Args args) {
    extern __shared__ __attribute__((aligned(16))) unsigned char lds[];
    Frame F;
    F.lds = lds; F.tid = threadIdx.x; F.lane = F.tid & 63; F.wave = __builtin_amdgcn_readfirstlane(F.tid >> 6);
    F.G = gridDim.x; { const int bx = blockIdx.x; F.vcu = (F.G % 8 == 0) ? (bx % 8) * (F.G / 8) + bx / 8 : bx; }
    F.x = (const float*)args.in[0]; F.c = (const float*)args.in[1]; F.pos = (const int*)args.in[2]; F.w_ada = (const float*)args.in[3]; F.b_ada = (const float*)args.in[4];
    F.g_norm = (const float*)args.in[5]; F.w_in = (const float*)args.in[6]; F.w_dw = (const float*)args.in[7]; F.b_dw = (const float*)args.in[8];
    F.g_ln = (const float*)args.in[9]; F.b_ln = (const float*)args.in[10]; F.w_pw = (const float*)args.in[11]; F.b_pw = (const float*)args.in[12];
    F.w_out = (const float*)args.in[13]; F.g_final = (const float*)args.in[14];
    F.out = args.out; F.ws = args.ws;
    const int lo = args.ph_lo, hi = args.ph_hi;
#define IN(k) (lo <= (k) && (k) < hi)
#define SEAM(k) do { if (IN(k) && IN((k) + 1)) cg::this_grid().sync(); } while (0)
    PG8_LAS unsigned char* ldsl = (PG8_LAS unsigned char*)lds;
    if (IN(0)) { p0_mod(F); p0_rope(F); p0_weights(F); }
    SEAM(0);
    if (IN(1)) p1_h(F);
    SEAM(1);
    if (IN(2)) {
        pg8::Gemm g{(const bf16*)(F.ws + WS_H), (const bf16*)(F.ws + WS_WIN), T_, DIN, D_}; pg8::StaticOrder S; S.init(T_, DIN, F.G, (int)blockIdx.x);
        EpiProj E{(bf16*)(F.ws + WS_U), (bf16*)(F.ws + WS_SGC), (bf16*)(F.ws + WS_Q), (bf16*)(F.ws + WS_K), (bf16*)(F.ws + WS_V), (bf16*)(F.ws + WS_SGA), (const float*)(F.ws + WS_ROPE), (float*)(F.ws + WS_KMEAN)};
        pg8::gemm_phase<EpiProj, pg8::StaticOrder, true, true>(ldsl, g, S, E);
    }
    SEAM(2);
    if (IN(3)) { n3_conv(F); n3_attn(F); }
    SEAM(3);
    if (IN(4)) {
        pg8::Gemm g{(const bf16*)(F.ws + WS_ALN), (const bf16*)(F.ws + WS_WPW), T_, DC, DC}; pg8::StaticOrder S; S.init(T_, DC, F.G, (int)blockIdx.x);
        EpiPw E{(bf16*)(F.ws + WS_YCAT), (const bf16*)(F.ws + WS_SGC), F.b_pw};
        pg8::gemm_phase<EpiPw, pg8::StaticOrder, true, true>(ldsl, g, S, E);
    }
    SEAM(4);
    if (IN(5)) {
        pg8::Gemm g{(const bf16*)(F.ws + WS_YCAT), (const bf16*)(F.ws + WS_WOUT), T_, D_, D_}; pg8::StaticOrder S; S.init(T_, D_, F.G, (int)blockIdx.x);
        EpiOut E{F.out, F.x, (const float*)(F.ws + WS_MOD)};
        pg8::gemm_phase<EpiOut, pg8::StaticOrder, true, true>(ldsl, g, S, E);
    }
    SEAM(5);
    if (IN(6)) p6_final(F);
#undef IN
#undef SEAM
}

extern "C" void kernel_launch(void* const* d_in, const int* in_sizes, int n_in, void* d_out, int out_size, void* d_ws, size_t ws_size, hipStream_t stream) {
    static int grid = 0;
    if (grid == 0) {
        if (n_in != 15 || out_size != T_ * D_ || ws_size < WS_END) { fprintf(stderr, "kernel_launch: unexpected problem (n_in %d out %d ws %zu)\n", n_in, out_size, ws_size); grid = -1; return; }
        int dev = 0, cus = 0, per_cu = 0;
        hipGetDevice(&dev); hipDeviceGetAttribute(&cus, hipDeviceAttributeMultiprocessorCount, dev);
        hipFuncSetAttribute((const void*)mk_fwd, hipFuncAttributeMaxDynamicSharedMemorySize, LDS_BYTES);
        hipOccupancyMaxActiveBlocksPerMultiprocessor(&per_cu, (const void*)mk_fwd, 512, LDS_BYTES);
        if (per_cu < 1) per_cu = 1;
        (void)hipGetLastError();
        grid = cus * per_cu;
    }
    if (grid < 0) return;
    hipMemsetAsync((char*)d_ws + WS_CTL, 0, CTL_ZERO, stream);
    Args a{};
    for (int i = 0; i < 15; ++i) a.in[i] = d_in[i];
    a.out = (float*)d_out; a.ws = (unsigned char*)d_ws;
    a.ph_lo = 0; a.ph_hi = NPH;
    void* kargs[] = {&a};
    hipError_t e = hipLaunchCooperativeKernel((const void*)mk_fwd, dim3(grid), dim3(512), kargs, LDS_BYTES, stream);
    if (e != hipSuccess) fprintf(stderr, "cooperative launch failed: %s (grid %d)\n", hipGetErrorString(e), grid);
}
```

```cpp
#include <hip/hip_runtime.h>
#include <hip/hip_cooperative_groups.h>
#include <cstdio>
#include <cstdint>
namespace cg = cooperative_groups;

constexpr int NB_ = 8, S_ = 4096, T_ = NB_ * S_, D_ = 1024, DIN = 3584, DC = 512, NH = 8, HD = 64, KB = 256, NKB = S_ / KB, CW = 31;
constexpr float EPS_ = 1e-6f;
constexpr float C2 = 0.125f * 1.4426950408889634f;

typedef unsigned short bf16;
typedef unsigned u32x4 __attribute__((ext_vector_type(4)));
typedef float f32x4 __attribute__((ext_vector_type(4)));

constexpr size_t MiB = 1u << 20;
constexpr size_t WS_CTL = 0;
constexpr size_t CTL_ZERO = 2 * MiB;
constexpr size_t WS_KMEAN = 1 * MiB;
constexpr size_t WS_MODP = 2 * MiB;
constexpr size_t WS_MOD = 2 * MiB + 512 * 1024;
constexpr size_t WS_ROPE = 3 * MiB;
constexpr size_t WS_WIN = 6 * MiB;
constexpr size_t WS_WPW = 13 * MiB;
constexpr size_t WS_WOUT = 14 * MiB;
constexpr size_t WS_H = 16 * MiB;
constexpr size_t WS_U = 80 * MiB;
constexpr size_t WS_SGC = 112 * MiB;
constexpr size_t WS_Q = 144 * MiB;
constexpr size_t WS_K = 176 * MiB;
constexpr size_t WS_V = 208 * MiB;
constexpr size_t WS_SGA = 240 * MiB;
constexpr size_t WS_ALN = 272 * MiB;
constexpr size_t WS_YCAT = 304 * MiB;
constexpr size_t WS_P = 272 * MiB;
constexpr size_t WS_END = 496 * MiB;

constexpr int LDS_BYTES = 147456;

__device__ __forceinline__ float bf2f(unsigned b) { return __uint_as_float(b << 16); }
__device__ __forceinline__ unsigned f2bf(float f) { unsigned u = __float_as_uint(f); return (u + 0x7fffu + ((u >> 16) & 1u)) >> 16; }
__device__ __forceinline__ unsigned pk2(float lo, float hi) { return f2bf(lo) | (f2bf(hi) << 16); }
__device__ __forceinline__ float silu_f(float v) { return v / (1.f + __expf(-v)); }
__device__ __forceinline__ float sigm_f(float v) { return 1.f / (1.f + __expf(-v)); }
__device__ __forceinline__ float wave_sum(float v) {
#pragma unroll
    for (int o = 1; o < 64; o <<= 1) v += __shfl_xor(v, o);
    return v;
}
__device__ __forceinline__ float wave_max(float v) {
#pragma unroll
    for (int o = 1; o < 64; o <<= 1) v = fmaxf(v, __shfl_xor(v, o));
    return v;
}
__device__ __forceinline__ void unpack8(const u32x4 v, float (&f)[8]) {
    f[0] = bf2f(v.x & 0xffffu); f[1] = bf2f(v.x >> 16); f[2] = bf2f(v.y & 0xffffu); f[3] = bf2f(v.y >> 16);
    f[4] = bf2f(v.z & 0xffffu); f[5] = bf2f(v.z >> 16); f[6] = bf2f(v.w & 0xffffu); f[7] = bf2f(v.w >> 16);
}
__device__ __forceinline__ u32x4 pack8(const float (&f)[8]) {
    u32x4 o; o.x = pk2(f[0], f[1]); o.y = pk2(f[2], f[3]); o.z = pk2(f[4], f[5]); o.w = pk2(f[6], f[7]); return o;
}

struct Frame {
    unsigned char* lds;
    int tid, lane, wave, vcu, G;
    const float *x, *c, *w_ada, *b_ada, *g_norm, *w_in, *w_dw, *b_dw, *g_ln, *b_ln, *w_pw, *b_pw, *w_out, *g_final;
    const int* pos;
    float* out; unsigned char* ws;
};

__device__ __forceinline__ int mk_lane() { int l = (int)__builtin_amdgcn_mbcnt_hi(~0u, __builtin_amdgcn_mbcnt_lo(~0u, 0u)); asm volatile("" : "+v"(l)); return l; }
namespace pg8 {
#define PG8_LAS __attribute__((address_space(3)))
typedef unsigned short bf16_t;
typedef short bf16x8 __attribute__((ext_vector_type(8)));
typedef float f32x4 __attribute__((ext_vector_type(4)));
typedef unsigned u32x4 __attribute__((ext_vector_type(4)));
constexpr int BM = 256, BK = 64, HALF = 128, HTB = HALF * BK * 2  , STAGE_BYTES = 8 * HTB, NXCD = 8, WGM = 8;

__host__ __device__ __forceinline__ int lds_byte(int r, int c) { const int st = (r >> 4) * 2 + (c >> 5), rr = r & 15, cc = c & 31, ob = rr * 64 + cc * 2; return st * 1024 + (ob ^ (((ob >> 9) & 1) << 5)); }
__host__ __device__ __forceinline__ void stage_rc(int b, int& R, int& C) { const int st = b / 1024, sb = b % 1024, swz = sb ^ (((sb >> 9) & 1) << 5); R = (st >> 1) * 16 + swz / 64; C = (st & 1) * 32 + (swz % 64) / 2; }
__host__ __device__ __forceinline__ int perm32(int rho) { const int n = rho >> 4, i = rho & 15; return 8 * (i >> 2) + 4 * n + (i & 3); }

struct Unit { int pm, pn; };
struct Gemm { const bf16_t* A; const bf16_t* Bt; int M, N, K; };

struct StaticOrder {
    int nM, nN, nwg, G, c;
    __host__ __device__ void init(int M, int N, int G_, int c_) { nM = M / BM; nN = N / BM; nwg = nM * nN; G = G_; c = c_; }
    __host__ __device__ bool next(int i, Unit& u) const {
        const long L = (long)i * G + c; if (L >= nwg) return false;
        int wgid = (int)L; { const int q = nwg / NXCD, r = nwg % NXCD, xcd = wgid % NXCD, off = wgid / NXCD; wgid = (xcd < r ? xcd * (q + 1) : r * (q + 1) + (xcd - r) * q) + off; }
        const int nig = WGM * nN, gid = wgid / nig, fm = gid * WGM, gsz = (nM - fm) < WGM ? (nM - fm) : WGM;
        u.pm = fm + ((wgid % nig) % gsz); u.pn = (wgid % nig) / gsz; return true;
    }
    __device__ __forceinline__ void a_ready(const Unit&) const {}
    __device__ __forceinline__ void done(const Unit&) const {}
};

__device__ __forceinline__ unsigned cvt_pk_bf16(float lo, float hi) { unsigned r; asm volatile("v_cvt_pk_bf16_f32 %0, %1, %2" : "=v"(r) : "v"(lo), "v"(hi)); return r; }
typedef float f32x2 __attribute__((ext_vector_type(2)));
template <class Epi, class Sched, bool ALIGN_EPI = false, bool SP2 = false>
__device__ __forceinline__ void gemm_phase(PG8_LAS unsigned char* lds, const Gemm g, const Sched& S, const Epi& E, int wave_s) {
    const int lane = mk_lane(), wid = __builtin_amdgcn_readfirstlane(wave_s), tid = wid * 64 + lane, wr = wid >> 2, wc = wid & 3, fr = lane & 15, fq = lane >> 4;
    const int K = g.K, nt = K / BK;
    unsigned voffA[2], voffB[2];
#pragma unroll
    for (int i = 0; i < 2; ++i) { int R, C; stage_rc(tid * 16 + i * 8192, R, C); const int Rb = Epi::PERM ? ((R & ~31) + perm32(R & 31)) : R;
        voffA[i] = (unsigned)(R * K + C) * 2u; voffB[i] = (unsigned)(Rb * K + C) * 2u; }
    const size_t kstep = (size_t)(BK * 2);
    const size_t hstep = (size_t)HALF * K * 2;
    const size_t tstep = 2 * hstep;
    const unsigned ldsw = (unsigned)wid * 1024u;
    const int aoff = lds_byte(wr * 64 + fr, fq * 8), boff = lds_byte(wc * 32 + fr, fq * 8);
#define PG8_SA(b, h) (((b) * 2 + (h)) * HTB)
#define PG8_SB(b, h) ((4 + (b) * 2 + (h)) * HTB)
#define PG8_STAGE(bufoff, gbase, voff) do { _Pragma("unroll") for (int _i = 0; _i < 2; ++_i) \
        __builtin_amdgcn_global_load_lds((const unsigned*)((const char*)(gbase) + (voff)[_i]), (PG8_LAS unsigned*)(lds + (bufoff) + ldsw + _i * 8192), 16, 0, 0); } while (0)
#define PG8_LDA(dst, b, h) do { _Pragma("unroll") for (int m = 0; m < 4; ++m) _Pragma("unroll") for (int k = 0; k < 2; ++k) dst[m][k] = *(const PG8_LAS bf16x8*)(lds + PG8_SA(b, h) + aoff + m * 2048 + k * 1024); } while (0)
#define PG8_LDB(dst, b, h) do { _Pragma("unroll") for (int n = 0; n < 2; ++n) _Pragma("unroll") for (int k = 0; k < 2; ++k) dst[n][k] = *(const PG8_LAS bf16x8*)(lds + PG8_SB(b, h) + boff + n * 2048 + k * 1024); } while (0)
#define PG8_MMA(ai, bj, At, Bt) do { __builtin_amdgcn_s_setprio(1); _Pragma("unroll") for (int m = 0; m < 4; ++m) _Pragma("unroll") for (int n = 0; n < 2; ++n) _Pragma("unroll") for (int k = 0; k < 2; ++k) \
        acc[ai][bj][m][n] = __builtin_amdgcn_mfma_f32_16x16x32_bf16(Bt[n][k], At[m][k], acc[ai][bj][m][n], 0, 0, 0); __builtin_amdgcn_s_setprio(0); } while (0)
#define PG8_WAIT_V(n) asm volatile("s_waitcnt vmcnt(" #n ")" ::: "memory")
#define PG8_WAIT_L(n) asm volatile("s_waitcnt lgkmcnt(" #n ")" ::: "memory")
#define PG8_BAR __builtin_amdgcn_s_barrier()
#define PG8_SCHED __builtin_amdgcn_sched_barrier(0)
    Unit cur, nxt; int ui = 0;
    if (!S.next(0, cur)) return;
    f32x4 acc[2][2][4][2];
#pragma unroll
    for (int a = 0; a < 2; ++a)
#pragma unroll
        for (int b = 0; b < 2; ++b)
#pragma unroll
            for (int m = 0; m < 4; ++m)
#pragma unroll
                for (int n = 0; n < 2; ++n) acc[a][b][m][n] = (f32x4){0.f, 0.f, 0.f, 0.f};
    bf16x8 At[4][2], B0[2][2], B1[2][2];
    const char* cA = (const char*)g.A + (size_t)cur.pm * tstep; const char* cB = (const char*)g.Bt + (size_t)cur.pn * tstep;
    S.a_ready(cur);
    if constexpr (SP2) {
        PG8_STAGE(PG8_SB(0, 0), cB, voffB); PG8_STAGE(PG8_SB(0, 1), cB + hstep, voffB); PG8_STAGE(PG8_SA(0, 0), cA, voffA); PG8_STAGE(PG8_SA(0, 1), cA + hstep, voffA);
        if (wr == 1) PG8_BAR;
        PG8_WAIT_V(2); PG8_BAR;
        PG8_STAGE(PG8_SB(1, 0), cB + kstep, voffB); PG8_STAGE(PG8_SA(1, 0), cA + kstep, voffA); PG8_STAGE(PG8_SB(1, 1), cB + hstep + kstep, voffB);
        PG8_WAIT_V(6); PG8_BAR;
    } else {
        PG8_STAGE(PG8_SB(0, 0), cB, voffB); PG8_STAGE(PG8_SA(0, 0), cA, voffA); PG8_STAGE(PG8_SB(0, 1), cB + hstep, voffB); PG8_STAGE(PG8_SA(0, 1), cA + hstep, voffA);
        if (wr == 1) PG8_BAR;
        PG8_WAIT_V(4); PG8_BAR;
        PG8_STAGE(PG8_SB(1, 0), cB + kstep, voffB); PG8_STAGE(PG8_SA(1, 0), cA + kstep, voffA); PG8_STAGE(PG8_SB(1, 1), cB + hstep + kstep, voffB);
        PG8_WAIT_V(6); PG8_BAR;
    }
    for (;;) {
        const bool has_next = S.next(ui + 1, nxt);
        const char* nA = has_next ? (const char*)g.A + (size_t)nxt.pm * tstep : cA; const char* nB = has_next ? (const char*)g.Bt + (size_t)nxt.pn * tstep : cB;
        for (int t = 0; t < nt; t += 2) {
            const bool last = (t == nt - 2);
            const char* a1 = cA + (size_t)(t + 1) * kstep;
            const char* a2 = last ? nA : cA + (size_t)(t + 2) * kstep; const char* b2 = last ? nB : cB + (size_t)(t + 2) * kstep;
            const char* a3 = a2 + kstep; const char* b3 = b2 + kstep;
            if (last && has_next) S.a_ready(nxt);
            if constexpr (SP2) {
            PG8_LDB(B0, 0, 0); PG8_LDB(B1, 0, 1); PG8_SCHED; PG8_LDA(At, 0, 0); PG8_STAGE(PG8_SA(1, 1), a1 + hstep, voffA);
            PG8_WAIT_V(8); PG8_WAIT_L(0); PG8_BAR; PG8_MMA(0, 0, At, B0); PG8_MMA(0, 1, At, B1); PG8_BAR; PG8_SCHED;
            PG8_LDA(At, 0, 1); PG8_STAGE(PG8_SB(0, 0), b2, voffB); PG8_STAGE(PG8_SB(0, 1), b2 + hstep, voffB); PG8_STAGE(PG8_SA(0, 0), a2, voffA);
            PG8_WAIT_V(8); PG8_WAIT_L(0); PG8_BAR; PG8_MMA(1, 0, At, B0); PG8_MMA(1, 1, At, B1); PG8_BAR; PG8_SCHED;
            PG8_LDB(B0, 1, 0); PG8_LDB(B1, 1, 1); PG8_SCHED; PG8_LDA(At, 1, 0); PG8_STAGE(PG8_SA(0, 1), a2 + hstep, voffA);
            PG8_WAIT_V(8); PG8_WAIT_L(0); PG8_BAR; PG8_MMA(0, 0, At, B0); PG8_MMA(0, 1, At, B1); PG8_BAR; PG8_SCHED;
            PG8_LDA(At, 1, 1); PG8_STAGE(PG8_SB(1, 0), b3, voffB); PG8_STAGE(PG8_SB(1, 1), b3 + hstep, voffB); PG8_STAGE(PG8_SA(1, 0), a3, voffA);
            PG8_WAIT_V(8); PG8_WAIT_L(0); PG8_BAR; PG8_MMA(1, 0, At, B0); PG8_MMA(1, 1, At, B1); PG8_BAR; PG8_SCHED;
            } else {
            PG8_LDB(B0, 0, 0); PG8_SCHED; PG8_LDA(At, 0, 0); PG8_STAGE(PG8_SA(1, 1), a1 + hstep, voffA);
            PG8_WAIT_L(8); PG8_BAR; PG8_WAIT_L(0); PG8_MMA(0, 0, At, B0); PG8_BAR; PG8_SCHED;
            PG8_LDB(B1, 0, 1); PG8_STAGE(PG8_SB(0, 0), b2, voffB);
            PG8_BAR; PG8_WAIT_L(0); PG8_MMA(0, 1, At, B1); PG8_BAR;
            PG8_LDA(At, 0, 1); PG8_STAGE(PG8_SA(0, 0), a2, voffA);
            PG8_BAR; PG8_WAIT_L(0); PG8_MMA(1, 0, At, B0); PG8_BAR; PG8_SCHED;
            PG8_STAGE(PG8_SB(0, 1), b2 + hstep, voffB);
            PG8_WAIT_V(6); PG8_BAR; PG8_MMA(1, 1, At, B1); PG8_BAR;
            PG8_LDB(B0, 1, 0); PG8_SCHED; PG8_LDA(At, 1, 0); PG8_STAGE(PG8_SA(0, 1), a2 + hstep, voffA);
            PG8_WAIT_L(8); PG8_BAR; PG8_WAIT_L(0); PG8_MMA(0, 0, At, B0); PG8_BAR; PG8_SCHED;
            PG8_LDB(B1, 1, 1); PG8_STAGE(PG8_SB(1, 0), b3, voffB);
            PG8_BAR; PG8_WAIT_L(0); PG8_MMA(0, 1, At, B1); PG8_BAR;
            PG8_LDA(At, 1, 1); PG8_STAGE(PG8_SA(1, 0), a3, voffA);
            PG8_BAR; PG8_WAIT_L(0); PG8_MMA(1, 0, At, B0); PG8_BAR; PG8_SCHED;
            PG8_STAGE(PG8_SB(1, 1), b3 + hstep, voffB);
            PG8_WAIT_V(6); PG8_BAR; PG8_MMA(1, 1, At, B1); PG8_BAR;
            }
        }
        if constexpr (ALIGN_EPI) { if (wr == 0) PG8_BAR; }
        if constexpr (!Epi::AFTER_DRAIN) { E(acc, cur, wr, wc, fr, fq); S.done(cur); }
        if (!has_next) break;
#pragma unroll
        for (int a = 0; a < 2; ++a)
#pragma unroll
            for (int b = 0; b < 2; ++b)
#pragma unroll
                for (int m = 0; m < 4; ++m)
#pragma unroll
                    for (int n = 0; n < 2; ++n) acc[a][b][m][n] = (f32x4){0.f, 0.f, 0.f, 0.f};
        cur = nxt; cA = nA; cB = nB; ++ui;
        if constexpr (ALIGN_EPI) { if (wr == 1) PG8_BAR; }
    }
    PG8_WAIT_V(0);
    if constexpr (!ALIGN_EPI) { if (wr == 0) PG8_BAR; }
    PG8_BAR;
    if constexpr (Epi::AFTER_DRAIN) { E.fused(acc, cur, wr, wc, fr, fq, lds, wid, lane); S.done(cur); }
#undef PG8_SA
#undef PG8_SB
#undef PG8_STAGE
#undef PG8_LDA
#undef PG8_LDB
#undef PG8_MMA
#undef PG8_WAIT_V
#undef PG8_WAIT_L
#undef PG8_BAR
#undef PG8_SCHED
}
}

__device__ __forceinline__ int colmap_in(int n) {
    const int tile = n >> 8, w = n & 255;
    if (tile < 4) return ((w >> 7) ? 512 : 0) + tile * 128 + (w & 127);
    if (tile >= 6 && tile < 10) { const int vd = n & 63; if (vd < 16) { const int g = vd >> 3, e = vd & 7; return (n & ~63) + ((e < 4) ? 4 * g + e : 8 + 4 * g + (e - 4)); } }
    return n;
}
__device__ __forceinline__ u32x4 pack2v(const f32x4 a, const f32x4 b) { u32x4 w; w.x = pg8::cvt_pk_bf16(a[0], a[1]); w.y = pg8::cvt_pk_bf16(a[2], a[3]); w.z = pg8::cvt_pk_bf16(b[0], b[1]); w.w = pg8::cvt_pk_bf16(b[2], b[3]); return w; }
__device__ __forceinline__ f32x4 sigm4(const f32x4 g) { f32x4 r; r.x = sigm_f(g.x); r.y = sigm_f(g.y); r.z = sigm_f(g.z); r.w = sigm_f(g.w); return r; }
struct EpiProj {
    static constexpr bool PERM = true, AFTER_DRAIN = false;
    bf16 *U, *SGC, *Q, *K, *V, *SGA; const float* ROPE; float* KM;
    __device__ __forceinline__ void operator()(const f32x4 (&acc)[2][2][4][2], const pg8::Unit& u, int wr, int wc, int fr, int fq) const {
        const int row0 = u.pm * 256 + wr * 64 + fr, colw = wc * 32 + 8 * fq, pn = u.pn;
        if (pn < 4) {
#pragma unroll
            for (int ai = 0; ai < 2; ++ai)
#pragma unroll
                for (int m = 0; m < 4; ++m) { const int row = row0 + ai * 128 + m * 16;
                    const f32x4 o0 = acc[ai][0][m][0] * sigm4(acc[ai][1][m][0]), o1 = acc[ai][0][m][1] * sigm4(acc[ai][1][m][1]);
                    *(u32x4*)(U + (size_t)row * DC + pn * 128 + colw) = pack2v(o0, o1); }
            return;
        }
        const int sec = (pn - 4) >> 1, cb = ((pn - 4) & 1) * 256;
        bf16* base = (sec == 0) ? SGC : (sec == 1) ? Q : (sec == 2) ? K : (sec == 3) ? V : SGA;
        const bool is_qk = (sec == 1 || sec == 2), rope_w = is_qk && !(wc & 1), rope_l = rope_w && fq < 2;
        f32x4 ks[2][2];
#pragma unroll
        for (int bj = 0; bj < 2; ++bj) { ks[bj][0] = (f32x4){0.f, 0.f, 0.f, 0.f}; ks[bj][1] = (f32x4){0.f, 0.f, 0.f, 0.f}; }
#pragma unroll
        for (int ai = 0; ai < 2; ++ai)
#pragma unroll
            for (int m = 0; m < 4; ++m) { const int row = row0 + ai * 128 + m * 16;
                f32x4 cs0 = (f32x4){1.f, 0.f, 1.f, 0.f}, cs1 = cs0;
                if (rope_w) { const f32x4* rp = (const f32x4*)(ROPE + ((size_t)row * 8 + 4 * (fq & 1)) * 2); cs0 = rp[0]; cs1 = rp[1]; }
#pragma unroll
                for (int bj = 0; bj < 2; ++bj) { f32x4 v0 = acc[ai][bj][m][0], v1 = acc[ai][bj][m][1];
                    if (sec == 0 || sec == 4) { v0 = v0 * sigm4(v0); v1 = v1 * sigm4(v1); }
                    else if (is_qk) {
                        if (rope_w) { const f32x4 co = (f32x4){cs0.x, cs0.z, cs1.x, cs1.z}, si = (f32x4){cs0.y, cs0.w, cs1.y, cs1.w};
                            const f32x4 r1 = v0 * co - v1 * si, r2 = v1 * co + v0 * si;
                            if (rope_l) { v0 = r1; v1 = r2; } }
                        if (sec == 1) { v0 = v0 * C2; v1 = v1 * C2; } else { ks[bj][0] += v0; ks[bj][1] += v1; }
                    }
                    *(u32x4*)(base + (size_t)row * DC + cb + bj * 128 + colw) = pack2v(v0, v1); } }
        if (sec == 2) {
            const int b = u.pm >> 4, blk = u.pm & 15;
#pragma unroll
            for (int bj = 0; bj < 2; ++bj)
#pragma unroll
                for (int n = 0; n < 2; ++n)
#pragma unroll
                    for (int e = 0; e < 4; ++e) { float s = ks[bj][n][e];
                        s += __shfl_xor(s, 1); s += __shfl_xor(s, 2); s += __shfl_xor(s, 4); s += __shfl_xor(s, 8);
                        if (fr == 0) { const int kc = cb + bj * 128 + colw + 4 * n + e; atomicAdd(KM + (((size_t)b * NH + (kc >> 6)) * NKB + blk) * HD + (kc & 63), s * (1.f / KB)); } }
        }
    }
};
struct EpiPw {
    static constexpr bool PERM = true, AFTER_DRAIN = false;
    bf16* Y; const bf16* SGC; const float* bias;
    __device__ __forceinline__ void operator()(const f32x4 (&acc)[2][2][4][2], const pg8::Unit& u, int wr, int wc, int fr, int fq) const {
        const int row0 = u.pm * 256 + wr * 64 + fr, col0 = u.pn * 256 + wc * 32 + 8 * fq;
        f32x4 bv[2][2];
#pragma unroll
        for (int bj = 0; bj < 2; ++bj) { bv[bj][0] = *(const f32x4*)(bias + col0 + bj * 128); bv[bj][1] = *(const f32x4*)(bias + col0 + bj * 128 + 4); }
#pragma unroll
        for (int ai = 0; ai < 2; ++ai)
#pragma unroll
            for (int m = 0; m < 4; ++m) { const int row = row0 + ai * 128 + m * 16;
#pragma unroll
                for (int bj = 0; bj < 2; ++bj) { float g[8]; unpack8(*(const u32x4*)(SGC + (size_t)row * DC + col0 + bj * 128), g);
                    const f32x4 v0 = (acc[ai][bj][m][0] + bv[bj][0]) * (f32x4){g[0], g[1], g[2], g[3]}, v1 = (acc[ai][bj][m][1] + bv[bj][1]) * (f32x4){g[4], g[5], g[6], g[7]};
                    *(u32x4*)(Y + (size_t)row * D_ + col0 + bj * 128) = pack2v(v0, v1); } }
    }
};
struct EpiOut {
    static constexpr bool PERM = false, AFTER_DRAIN = false;
    float* O; const float* x; const float* MOD;
    __device__ __forceinline__ void operator()(const f32x4 (&acc)[2][2][4][2], const pg8::Unit& u, int wr, int wc, int fr, int fq) const {
        const int row0 = u.pm * 256 + wr * 64 + fr, col0 = u.pn * 256 + wc * 32 + 4 * fq, b = u.pm >> 4;
        f32x4 gv[2][2];
#pragma unroll
        for (int bj = 0; bj < 2; ++bj)
#pragma unroll
            for (int n = 0; n < 2; ++n) gv[bj][n] = *(const f32x4*)(MOD + (size_t)b * 3072 + 2048 + col0 + bj * 128 + n * 16);
#pragma unroll
        for (int ai = 0; ai < 2; ++ai)
#pragma unroll
            for (int m = 0; m < 4; ++m) { const size_t off = (size_t)(row0 + ai * 128 + m * 16) * D_ + col0;
#pragma unroll
                for (int bj = 0; bj < 2; ++bj)
#pragma unroll
                    for (int n = 0; n < 2; ++n) { const f32x4 xv = *(const f32x4*)(x + off + bj * 128 + n * 16);
                        *(f32x4*)(O + off + bj * 128 + n * 16) = xv + gv[bj][n] * acc[ai][bj][m][n]; } }
    }
};

template <bool MAP>
__device__ __forceinline__ void p0_transpose_item(const float* W, int K, int N, bf16* WT, float* scr, int item, int lane) {
    const int nblk = N / 32, kb = item / nblk, nb = item % nblk, k0 = 64 * kb, n0 = 32 * nb;
    const int ncol = MAP ? colmap_in(n0 + (lane & 31)) : n0 + (lane & 31);
#pragma unroll 8
    for (int i = 0; i < 32; ++i) { const int kk = 2 * i + (lane >> 5); scr[kk * 33 + (lane & 31)] = W[(size_t)(k0 + kk) * N + ncol]; }
    __builtin_amdgcn_s_waitcnt(0); __builtin_amdgcn_wave_barrier();
    const int c = lane & 7;
#pragma unroll
    for (int j = 0; j < 4; ++j) { const int n = (lane >> 3) + 8 * j; const float* s = scr + (8 * c) * 33 + n;
        u32x4 o; o.x = pk2(s[0 * 33], s[1 * 33]); o.y = pk2(s[2 * 33], s[3 * 33]); o.z = pk2(s[4 * 33], s[5 * 33]); o.w = pk2(s[6 * 33], s[7 * 33]);
        *(u32x4*)(WT + (size_t)(n0 + n) * K + k0 + 8 * c) = o; }
    __builtin_amdgcn_s_waitcnt(0); __builtin_amdgcn_wave_barrier();
}

__device__ __forceinline__ void p0_mod(Frame& F) {
    float* red = (float*)F.lds;
    float* MODP = (float*)(F.ws + WS_MODP);
    for (int it = F.vcu; it < 48 * 4; it += F.G) {
        const int cc = it % 48, q = it / 48, n = cc * 64 + F.lane, k0 = q * 256 + F.wave * 32;
        float acc[8];
#pragma unroll
        for (int b = 0; b < 8; ++b) acc[b] = 0.f;
#pragma unroll 8
        for (int kk = 0; kk < 32; ++kk) {
            const float w = F.w_ada[(size_t)(k0 + kk) * 3072 + n];
#pragma unroll
            for (int b = 0; b < 8; ++b) { const float cv = F.c[b * D_ + k0 + kk]; acc[b] += silu_f(cv) * w; }
        }
        __syncthreads();
#pragma unroll
        for (int b = 0; b < 8; ++b) red[(F.wave * 8 + b) * 64 + F.lane] = acc[b];
        __syncthreads();
        {
            float s = 0.f;
#pragma unroll
            for (int w = 0; w < 8; ++w) s += red[(w * 8 + F.wave) * 64 + F.lane];
            MODP[((size_t)q * 8 + F.wave) * 3072 + n] = s;
        }
    }
    __syncthreads();
}
__device__ __forceinline__ void p0_rope(Frame& F) {
    float* ROPE = (float*)(F.ws + WS_ROPE);
    const int gt = F.vcu * 512 + F.tid, NT = F.G * 512;
    for (int e = gt; e < T_ * 8; e += NT) {
        const int t = e >> 3, i = e & 7;
        const double inv = (i == 0) ? 1.0 : (i == 1) ? 0.19392274474868576 : (i == 2) ? 0.03760603093086393 : (i == 3) ? 0.007292664737217109 :
                           (i == 4) ? 0.001414213562373095 : (i == 5) ? 0.0002742481756762073 : (i == 6) ? 5.318295896944988e-05 : 1.031338537721246e-05;
        const double rev = (double)F.pos[t] * inv * 0.15915494309189535;
        const float fr = (float)(rev - floor(rev));
        ROPE[2 * e] = __builtin_amdgcn_cosf(fr); ROPE[2 * e + 1] = __builtin_amdgcn_sinf(fr);
    }
}
__device__ __forceinline__ void p0_weights(Frame& F) {
    float* scr = (float*)(F.lds + 16384 + F.wave * 16384);
    const int gw = F.vcu * 8 + F.wave, NGW = F.G * 8;
    constexpr int I_IN = (D_ / 64) * (DIN / 32), I_PW = (DC / 64) * (DC / 32), I_OUT = (D_ / 64) * (D_ / 32);
    for (int it = gw; it < I_IN + I_PW + I_OUT; it += NGW) {
        int r = it;
        if (r < I_IN) { p0_transpose_item<true>(F.w_in, D_, DIN, (bf16*)(F.ws + WS_WIN), scr, r, F.lane); continue; } r -= I_IN;
        if (r < I_PW) { p0_transpose_item<false>(F.w_pw, DC, DC, (bf16*)(F.ws + WS_WPW), scr, r, F.lane); continue; } r -= I_PW;
        p0_transpose_item<false>(F.w_out, D_, D_, (bf16*)(F.ws + WS_WOUT), scr, r, F.lane);
    }
}
__device__ __forceinline__ float mod_at(Frame& F, int b, int n) {
    const float* MODP = (const float*)(F.ws + WS_MODP);
    float s = F.b_ada[n];
#pragma unroll
    for (int q = 0; q < 4; ++q) s += MODP[((size_t)q * 8 + b) * 3072 + n];
    return s;
}

__device__ __forceinline__ void p1_h(Frame& F) {
    bf16* Hb = (bf16*)(F.ws + WS_H);
    { float* MOD = (float*)(F.ws + WS_MOD); for (int e = F.vcu * 512 + F.tid; e < NB_ * 3072; e += F.G * 512) MOD[e] = mod_at(F, e / 3072, e % 3072); }
    const int gw = F.vcu * 8 + F.wave, NGW = F.G * 8, RPW = 16;
    for (int blk = gw; blk < T_ / RPW; blk += NGW) {
        const int r0 = blk * RPW, b = r0 / S_;
        f32x4 gs[4], sh[4];
#pragma unroll
        for (int j = 0; j < 4; ++j) {
            const int k = 4 * F.lane + 256 * j;
            float g4[4], s4[4];
#pragma unroll
            for (int e = 0; e < 4; ++e) { g4[e] = F.g_norm[k + e] * (1.f + mod_at(F, b, 1024 + k + e)); s4[e] = mod_at(F, b, k + e); }
            gs[j] = (f32x4){g4[0], g4[1], g4[2], g4[3]}; sh[j] = (f32x4){s4[0], s4[1], s4[2], s4[3]};
        }
        for (int r = r0; r < r0 + RPW; ++r) {
            const f32x4* xr = (const f32x4*)(F.x + (size_t)r * D_) + F.lane;
            f32x4 v[4]; float s = 0.f;
#pragma unroll
            for (int j = 0; j < 4; ++j) { v[j] = xr[64 * j]; s += (v[j].x * v[j].x + v[j].y * v[j].y) + (v[j].z * v[j].z + v[j].w * v[j].w); }
            const float rstd = rsqrtf(wave_sum(s) * (1.f / D_) + EPS_);
            unsigned long long* o8 = (unsigned long long*)(Hb + (size_t)r * D_) + F.lane;
#pragma unroll
            for (int j = 0; j < 4; ++j) { const f32x4 h = v[j] * rstd * gs[j] + sh[j];
                o8[64 * j] = (unsigned long long)pk2(h.x, h.y) | ((unsigned long long)pk2(h.z, h.w) << 32); }
        }
    }
}

template <class Epi>
__device__ __forceinline__ void naive_gemm(Frame& F, const bf16* A, int lda, const float* W, int M, int N, int K, const Epi& epi) {
    float* As = (float*)F.lds;
    float* Bs = As + 32 * 132;
    const int tid = F.tid, ty = tid >> 4, tx = tid & 15;
    const int ntn = N / 128, ntiles = (M / 128) * ntn;
    const int arow = tid >> 2, akq = (tid & 3) * 8, bkk = tid >> 4, bn8 = (tid & 15) * 8;
    for (int tile = F.vcu; tile < ntiles; tile += F.G) {
        const int tm = tile / ntn, tn = tile % ntn;
        float acc[4][8];
#pragma unroll
        for (int i = 0; i < 4; ++i)
#pragma unroll
            for (int j = 0; j < 8; ++j) acc[i][j] = 0.f;
        for (int k0 = 0; k0 < K; k0 += 32) {
            const u32x4 av = *(const u32x4*)(A + (size_t)(tm * 128 + arow) * lda + k0 + akq);
            const f32x4 b0 = *(const f32x4*)(W + (size_t)(k0 + bkk) * N + tn * 128 + bn8);
            const f32x4 b1 = *(const f32x4*)(W + (size_t)(k0 + bkk) * N + tn * 128 + bn8 + 4);
            __syncthreads();
            float af[8]; unpack8(av, af);
#pragma unroll
            for (int i = 0; i < 8; ++i) As[(akq + i) * 132 + arow] = af[i];
            *(f32x4*)&Bs[bkk * 132 + bn8] = b0; *(f32x4*)&Bs[bkk * 132 + bn8 + 4] = b1;
            __syncthreads();
#pragma unroll 8
            for (int kk = 0; kk < 32; ++kk) {
                const f32x4 a4 = *(const f32x4*)&As[kk * 132 + ty * 4];
                const f32x4 c0 = *(const f32x4*)&Bs[kk * 132 + tx * 8], c1 = *(const f32x4*)&Bs[kk * 132 + tx * 8 + 4];
                const float a[4] = {a4.x, a4.y, a4.z, a4.w}; const float bb[8] = {c0.x, c0.y, c0.z, c0.w, c1.x, c1.y, c1.z, c1.w};
#pragma unroll
                for (int i = 0; i < 4; ++i)
#pragma unroll
                    for (int j = 0; j < 8; ++j) acc[i][j] += a[i] * bb[j];
            }
        }
#pragma unroll
        for (int i = 0; i < 4; ++i) epi(tm * 128 + ty * 4 + i, tn * 128 + tx * 8, acc[i]);
    }
    __syncthreads();
}
struct EpiStoreBf16 { bf16* O; int ldc;
    __device__ __forceinline__ void operator()(int row, int col, const float (&v)[8]) const { *(u32x4*)(O + (size_t)row * ldc + col) = pack8(v); } };
struct EpiPwNaive { bf16* O; const bf16* SGC; const float* bias;
    __device__ __forceinline__ void operator()(int row, int col, const float (&v)[8]) const {
        float g[8], o[8]; unpack8(*(const u32x4*)(SGC + (size_t)row * DC + col), g);
#pragma unroll
        for (int j = 0; j < 8; ++j) o[j] = (v[j] + bias[col + j]) * g[j];
        *(u32x4*)(O + (size_t)row * D_ + col) = pack8(o); } };
struct EpiOutNaive { float* O; const float* x; const float* modp; const float* b_ada;
    __device__ __forceinline__ void operator()(int row, int col, const float (&v)[8]) const {
        const int b = row / S_;
#pragma unroll
        for (int j = 0; j < 8; ++j) { float g = b_ada[2048 + col + j];
#pragma unroll
            for (int q = 0; q < 4; ++q) g += modp[((size_t)q * 8 + b) * 3072 + 2048 + col + j];
            O[(size_t)row * D_ + col + j] = x[(size_t)row * D_ + col + j] + g * v[j]; } } };

__device__ __forceinline__ void n2_transform(Frame& F) {
    const bf16* P = (const bf16*)(F.ws + WS_P); const float* ROPE = (const float*)(F.ws + WS_ROPE);
    bf16 *U = (bf16*)(F.ws + WS_U), *SGC = (bf16*)(F.ws + WS_SGC), *Q = (bf16*)(F.ws + WS_Q), *K = (bf16*)(F.ws + WS_K), *V = (bf16*)(F.ws + WS_V), *SGA = (bf16*)(F.ws + WS_SGA);
    const int gw = F.vcu * 8 + F.wave, NGW = F.G * 8, c8 = F.lane * 8;
    for (int t = gw; t < T_; t += NGW) {
        const bf16* pr = P + (size_t)t * DIN;
        float a[8], g[8], o[8];
        unpack8(*(const u32x4*)(pr + c8), a); unpack8(*(const u32x4*)(pr + 512 + c8), g);
#pragma unroll
        for (int j = 0; j < 8; ++j) o[j] = a[j] * sigm_f(g[j]);
        *(u32x4*)(U + (size_t)t * DC + c8) = pack8(o);
        unpack8(*(const u32x4*)(pr + 1024 + c8), a);
#pragma unroll
        for (int j = 0; j < 8; ++j) o[j] = silu_f(a[j]);
        *(u32x4*)(SGC + (size_t)t * DC + c8) = pack8(o);
        float cs[8], sn[8];
#pragma unroll
        for (int j = 0; j < 8; ++j) { cs[j] = ROPE[((size_t)t * 8 + j) * 2]; sn[j] = ROPE[((size_t)t * 8 + j) * 2 + 1]; }
#pragma unroll
        for (int which = 0; which < 2; ++which) {
            unpack8(*(const u32x4*)(pr + (which ? 2048 : 1536) + c8), a);
            float p[8];
#pragma unroll
            for (int j = 0; j < 8; ++j) p[j] = __shfl_xor(a[j], 1);
            const int l7 = F.lane & 7;
#pragma unroll
            for (int j = 0; j < 8; ++j) { float r = a[j];
                if (l7 == 0) r = a[j] * cs[j] - p[j] * sn[j];
                else if (l7 == 1) r = a[j] * cs[j] + p[j] * sn[j];
                o[j] = which ? r : r * C2; }
            *(u32x4*)((which ? K : Q) + (size_t)t * DC + c8) = pack8(o);
        }
        *(u32x4*)(V + (size_t)t * DC + c8) = *(const u32x4*)(pr + 2560 + c8);
        unpack8(*(const u32x4*)(pr + 3072 + c8), a);
#pragma unroll
        for (int j = 0; j < 8; ++j) o[j] = silu_f(a[j]);
        *(u32x4*)(SGA + (size_t)t * DC + c8) = pack8(o);
    }
}
__device__ __forceinline__ void n2_kmean(Frame& F) {
    const bf16* K = (const bf16*)(F.ws + WS_K); float* KM = (float*)(F.ws + WS_KMEAN);
    const int gt = F.vcu * 512 + F.tid, NT = F.G * 512;
    for (int e = gt; e < NB_ * NKB * DC; e += NT) {
        const int col = e % DC, blk = (e / DC) % NKB, b = e / (DC * NKB);
        float s = 0.f;
        for (int r = 0; r < KB; ++r) s += bf2f(K[(size_t)(b * S_ + blk * KB + r) * DC + col]);
        KM[(((size_t)b * NH + col / HD) * NKB + blk) * HD + (col % HD)] = s * (1.f / KB);
    }
}

__device__ __forceinline__ void n3_conv(Frame& F) {
    const bf16* U = (const bf16*)(F.ws + WS_U); bf16* ALN = (bf16*)(F.ws + WS_ALN);
    const int gw = F.vcu * 8 + F.wave, NGW = F.G * 8, c8 = F.lane * 8;
    for (int t = gw; t < T_; t += NGW) {
        const int s = t % S_;
        float acc[8];
        { const f32x4 b0 = *(const f32x4*)(F.b_dw + c8), b1 = *(const f32x4*)(F.b_dw + c8 + 4);
          acc[0] = b0.x; acc[1] = b0.y; acc[2] = b0.z; acc[3] = b0.w; acc[4] = b1.x; acc[5] = b1.y; acc[6] = b1.z; acc[7] = b1.w; }
        for (int w = 0; w < CW; ++w) {
            const int sp = s - (CW - 1) + w;
            if (sp < 0) continue;
            float u[8]; unpack8(*(const u32x4*)(U + (size_t)(t - (CW - 1) + w) * DC + c8), u);
            const f32x4 k0 = *(const f32x4*)(F.w_dw + w * DC + c8), k1 = *(const f32x4*)(F.w_dw + w * DC + c8 + 4);
            acc[0] += u[0] * k0.x; acc[1] += u[1] * k0.y; acc[2] += u[2] * k0.z; acc[3] += u[3] * k0.w;
            acc[4] += u[4] * k1.x; acc[5] += u[5] * k1.y; acc[6] += u[6] * k1.z; acc[7] += u[7] * k1.w;
        }
        float sm = 0.f;
#pragma unroll
        for (int j = 0; j < 8; ++j) sm += acc[j];
        const float mu = wave_sum(sm) * (1.f / DC);
        float sq = 0.f;
#pragma unroll
        for (int j = 0; j < 8; ++j) { acc[j] -= mu; sq += acc[j] * acc[j]; }
        const float rstd = rsqrtf(wave_sum(sq) * (1.f / DC) + EPS_);
        float o[8];
#pragma unroll
        for (int j = 0; j < 8; ++j) o[j] = silu_f(acc[j] * rstd * F.g_ln[c8 + j] + F.b_ln[c8 + j]);
        *(u32x4*)(ALN + (size_t)t * DC + c8) = pack8(o);
    }
}

__device__ __forceinline__ void n3_attn(Frame& F) {
    const bf16 *Q = (const bf16*)(F.ws + WS_Q), *K = (const bf16*)(F.ws + WS_K), *V = (const bf16*)(F.ws + WS_V), *SGA = (const bf16*)(F.ws + WS_SGA);
    const float* KM = (const float*)(F.ws + WS_KMEAN); bf16* Y = (bf16*)(F.ws + WS_YCAT);
    float* qs = (float*)F.lds + F.wave * 64;
    float* ps = (float*)F.lds + 512 + F.wave * 1024;
    const int gw = F.vcu * 8 + F.wave, NGW = F.G * 8, lane = F.lane;
    for (int it = gw; it < T_ * NH; it += NGW) {
        const int h = it % NH, t = it / NH, b = t / S_, s = t % S_, qb = s / KB;
        const float qv = bf2f(Q[(size_t)t * DC + h * HD + lane]);
        qs[lane] = qv;
        __builtin_amdgcn_s_waitcnt(0); __builtin_amdgcn_wave_barrier();
        float gate = -3.0e38f;
        if (lane < qb) { const float* km = KM + (((size_t)b * NH + h) * NKB + lane) * HD; float g = 0.f;
            for (int d = 0; d < HD; ++d) g += qs[d] * km[d];
            gate = g; }
        int sel0 = -1, sel1 = -1, sel2 = -1;
        {
            float g0 = -3.0e38f, g1 = -3.0e38f, g2 = -3.0e38f;
            for (int j = 0; j < NKB; ++j) { const float gj = __shfl(gate, j);
                if (j < qb) {
                    if (gj > g0) { g2 = g1; sel2 = sel1; g1 = g0; sel1 = sel0; g0 = gj; sel0 = j; }
                    else if (gj > g1) { g2 = g1; sel2 = sel1; g1 = gj; sel1 = j; }
                    else if (gj > g2) { g2 = gj; sel2 = j; } } }
        }
        float lg[4][4]; float mx = -3.0e38f;
#pragma unroll
        for (int sl = 0; sl < 4; ++sl) {
            const int blk = (sl == 0) ? qb : (sl == 1) ? sel0 : (sl == 2) ? sel1 : sel2;
#pragma unroll
            for (int kk = 0; kk < 4; ++kk) {
                const int key = lane + 64 * kk; float l = -3.0e38f;
                if (blk >= 0 && (sl > 0 || blk * KB + key <= s)) {
                    const bf16* kr = K + (size_t)(b * S_ + blk * KB + key) * DC + h * HD; float a = 0.f;
#pragma unroll
                    for (int d8 = 0; d8 < 8; ++d8) { float kf[8]; unpack8(*(const u32x4*)(kr + d8 * 8), kf);
#pragma unroll
                        for (int e = 0; e < 8; ++e) a += qs[d8 * 8 + e] * kf[e]; }
                    l = a; }
                lg[sl][kk] = l; mx = fmaxf(mx, l);
            }
        }
        mx = wave_max(mx);
        float sum = 0.f;
#pragma unroll
        for (int sl = 0; sl < 4; ++sl)
#pragma unroll
            for (int kk = 0; kk < 4; ++kk) { const float p = (lg[sl][kk] > -1.0e38f) ? exp2f(lg[sl][kk] - mx) : 0.f; sum += p; ps[sl * 256 + lane + 64 * kk] = bf2f(f2bf(p)); }
        sum = wave_sum(sum);
        __builtin_amdgcn_s_waitcnt(0); __builtin_amdgcn_wave_barrier();
        float o = 0.f;
#pragma unroll
        for (int sl = 0; sl < 4; ++sl) {
            const int blk = (sl == 0) ? qb : (sl == 1) ? sel0 : (sl == 2) ? sel1 : sel2;
            if (blk < 0) continue;
            const int nk = (sl == 0) ? (s - qb * KB + 1) : KB;
            const bf16* vr = V + (size_t)(b * S_ + blk * KB) * DC + h * HD + lane;
            for (int key = 0; key < nk; ++key) o += ps[sl * 256 + key] * bf2f(vr[(size_t)key * DC]);
        }
        const float y = o / sum * bf2f(SGA[(size_t)t * DC + h * HD + lane]);
        Y[(size_t)t * D_ + DC + h * HD + lane] = (bf16)f2bf(y);
        __builtin_amdgcn_s_waitcnt(0); __builtin_amdgcn_wave_barrier();
    }
}

__device__ __forceinline__ void p6_final(Frame& F) {
    const int gw = F.vcu * 8 + F.wave, NGW = F.G * 8;
    f32x4 g[4];
#pragma unroll
    for (int j = 0; j < 4; ++j) g[j] = *((const f32x4*)F.g_final + F.lane + 64 * j);
    for (int r = gw; r < T_; r += NGW) {
        f32x4* xr = (f32x4*)(F.out + (size_t)r * D_) + F.lane;
        f32x4 v[4]; float s = 0.f;
#pragma unroll
        for (int j = 0; j < 4; ++j) { v[j] = xr[64 * j]; s += (v[j].x * v[j].x + v[j].y * v[j].y) + (v[j].z * v[j].z + v[j].w * v[j].w); }
        const float rstd = rsqrtf(wave_sum(s) * (1.f / D_) + EPS_);
#pragma unroll
        for (int j = 0; j < 4; ++j) xr[64 * j] = v[j] * rstd * g[j];
    }
}

#include <hip/hip_bf16.h>
#include <cmath>
namespace attn_body {
using bf16=__hip_bfloat16;
using bf16x8=__attribute__((ext_vector_type(8)))short;
using s16x4=__attribute__((ext_vector_type(4)))short;
using f32x16=__attribute__((ext_vector_type(16)))float;
using u32x4=__attribute__((ext_vector_type(4)))unsigned;
constexpr int BATCH=8,NHEAD=8,SEQ=4096,D=64,DM=NHEAD*D,YP=1024,YOFF=512;
constexpr int NW=8,QBLK=32,QB=QBLK*NW,KVBLK=64,NQB=SEQ/QB;
constexpr int ATTN_PITCH=DM, ATTN_UNIT_ROWS=QB;
__device__ __forceinline__ int crow(int r,int hi){return (r&3)+8*(r>>2)+4*hi;}
#define SBAR() __builtin_amdgcn_sched_barrier(0)
__device__ __forceinline__ void cmask(f32x16&p0,f32x16&p1,int jb,int qrel,int hi){
  const float NEG=-INFINITY; int kb=64*jb+4*hi;
  #pragma unroll
  for(int r=0;r<16;++r){int kv=kb+(r&3)+8*(r>>2); if(kv>qrel)p0[r]=NEG; if(kv+32>qrel)p1[r]=NEG;}
}

constexpr int NSLOT=3, SLOTB=8192;
constexpr int LDS_K=0, LDS_V=NSLOT*SLOTB, LDS_WS=2*NSLOT*SLOTB, LDS_OST=LDS_WS+NW*64*4, LDS_BYTES=LDS_OST+NW*4096;
constexpr float C2=0.125f*1.4426950408889634f;
__device__ __forceinline__ void glds16(const void*gsrc,unsigned lds_dst){unsigned keep;
  asm volatile("s_mov_b32 %0, m0\n\ts_mov_b32 m0, %2\n\ts_nop 0\n\tglobal_load_lds_dwordx4 %1, off\n\ts_mov_b32 m0, %0":"=&s"(keep):"v"(gsrc),"s"(lds_dst):"memory");}
__device__ __forceinline__ float max3f(float a,float b,float c){float r;asm("v_max3_f32 %0, %1, %2, %3":"=v"(r):"v"(a),"v"(b),"v"(c));return r;}
__device__ __forceinline__ float max2f(float a,float b){float r;asm("v_max_f32_e32 %0, %1, %2":"=v"(r):"v"(a),"v"(b));return r;}
__device__ __forceinline__ float fadd_s(float a,float b){float r;asm("v_add_f32_e32 %0, %1, %2":"=v"(r):"v"(a),"v"(b));return r;}
__device__ __forceinline__ float fsub_s(float a,float b){float r;asm("v_sub_f32_e32 %0, %1, %2":"=v"(r):"v"(a),"v"(b));return r;}
typedef float f32x2_t __attribute__((ext_vector_type(2))); typedef __bf16 bf16x2_t __attribute__((ext_vector_type(2)));
__device__ __forceinline__ unsigned cvtpk_s(float lo,float hi){f32x2_t v={lo,hi};bf16x2_t b=__builtin_convertvector(v,bf16x2_t);return __builtin_bit_cast(unsigned,b);}
#define WAIT_BAR(N) asm volatile("s_waitcnt vmcnt(" #N ") lgkmcnt(0)\n\ts_barrier":::"memory")

__device__ __forceinline__ void qkt(f32x16&p0,f32x16&p1,const char*Kslot,const bf16x8*qr,const f32x16&negm,int r32,int hi){
  const char*kb=Kslot+hi*1024+r32*16;
  #pragma unroll
  for(int d0=0;d0<4;++d0){
    const bf16x8 b0=*reinterpret_cast<const bf16x8*>(kb+d0*2048);
    const bf16x8 b1=*reinterpret_cast<const bf16x8*>(kb+d0*2048+512);
    if(d0==0){p0=__builtin_amdgcn_mfma_f32_32x32x16_bf16(b0,qr[0],negm,0,0,0);p1=__builtin_amdgcn_mfma_f32_32x32x16_bf16(b1,qr[0],negm,0,0,0);}
    else{p0=__builtin_amdgcn_mfma_f32_32x32x16_bf16(b0,qr[d0],p0,0,0,0);p1=__builtin_amdgcn_mfma_f32_32x32x16_bf16(b1,qr[d0],p1,0,0,0);}}
}
typedef __attribute__((address_space(3))) const char* lds_cptr;
typedef short v4i16_t __attribute__((ext_vector_type(4)));
__device__ __forceinline__ void kload8(bf16x8*kf,lds_cptr kp){
  kf[0]=*(const __attribute__((address_space(3))) bf16x8*)(kp);      kf[1]=*(const __attribute__((address_space(3))) bf16x8*)(kp+512);
  kf[2]=*(const __attribute__((address_space(3))) bf16x8*)(kp+2048); kf[3]=*(const __attribute__((address_space(3))) bf16x8*)(kp+2560);
  kf[4]=*(const __attribute__((address_space(3))) bf16x8*)(kp+4096); kf[5]=*(const __attribute__((address_space(3))) bf16x8*)(kp+4608);
  kf[6]=*(const __attribute__((address_space(3))) bf16x8*)(kp+6144); kf[7]=*(const __attribute__((address_space(3))) bf16x8*)(kp+6656);
}
__device__ __forceinline__ void kload2(bf16x8*kf,lds_cptr kp,int j){ kf[2*j]=*(const __attribute__((address_space(3))) bf16x8*)(kp+j*2048); kf[2*j+1]=*(const __attribute__((address_space(3))) bf16x8*)(kp+j*2048+512); }
__device__ __forceinline__ s16x4 vtr(lds_cptr p){ return __builtin_bit_cast(s16x4,__builtin_amdgcn_ds_read_tr16_b64_v4i16((__attribute__((address_space(3))) v4i16_t*)p)); }
__device__ __forceinline__ float rowmax(const f32x16&p0,const f32x16&p1){
  float a=max3f(p0[0],p0[1],p1[0]),b=max3f(p0[2],p0[3],p1[1]);a=max3f(a,p1[2],p1[3]);
  #pragma unroll
  for(int r=4;r<16;r+=4){a=max3f(a,p0[r],p0[r+1]);b=max3f(b,p0[r+2],p0[r+3]);a=max3f(a,p1[r],p1[r+1]);b=max3f(b,p1[r+2],p1[r+3]);}
  const float m=max2f(a,b);
  auto rr=__builtin_amdgcn_permlane32_swap(__float_as_uint(m),__float_as_uint(m),false,false);
  return max2f(__uint_as_float(rr[0]),__uint_as_float(rr[1]));
}
__device__ __forceinline__ void pv(f32x16*o,int vb,bf16x8 pa0,bf16x8 pa1,bf16x8 pa2,bf16x8 pa3){
  #pragma unroll
  for(int d0=0;d0<2;++d0){s16x4 lo[4],hi[4];
    #pragma unroll
    for(int ks=0;ks<4;++ks){
      asm volatile("ds_read_b64_tr_b16 %0,%1 offset:%c2":"=&v"(lo[ks]):"v"(vb),"i"(d0*4096+ks*1024):"memory");
      asm volatile("ds_read_b64_tr_b16 %0,%1 offset:%c2":"=&v"(hi[ks]):"v"(vb),"i"(d0*4096+ks*1024+512):"memory");}
    asm volatile("s_waitcnt lgkmcnt(0)":::"memory");SBAR();
    #define PK(k) (bf16x8){lo[k][0],lo[k][1],lo[k][2],lo[k][3],hi[k][0],hi[k][1],hi[k][2],hi[k][3]}
    o[d0]=__builtin_amdgcn_mfma_f32_32x32x16_bf16(pa0,PK(0),o[d0],0,0,0);
    o[d0]=__builtin_amdgcn_mfma_f32_32x32x16_bf16(pa1,PK(1),o[d0],0,0,0);
    o[d0]=__builtin_amdgcn_mfma_f32_32x32x16_bf16(pa2,PK(2),o[d0],0,0,0);
    o[d0]=__builtin_amdgcn_mfma_f32_32x32x16_bf16(pa3,PK(3),o[d0],0,0,0);
    #undef PK
  }
}

#ifndef ATTN_STORE16
#define ATTN_STORE16(p,v) (*(u32x4*)(p)=(v))
#endif
template<int THRL> __device__ __forceinline__ void attn_unit(int b,int h,int qb,const bf16*Q,const bf16*__restrict__ K,const bf16*__restrict__ V,bf16*O,const bf16*__restrict__ SG,const float*__restrict__ KM,char*shm,int wave_s){
  const int lane=mk_lane(),r32=lane&31,hi=lane>>5; const int wid=__builtin_amdgcn_readfirstlane(wave_s);
  const long rowbase=(long)b*SEQ; const int q0=qb*QB;
  const bf16*Qw=Q+(rowbase+q0+wid*QBLK)*DM+h*D;
  const bf16*Kh=K+rowbase*DM+h*D,*Vh=V+rowbase*DM+h*D;
  const unsigned lds0=(unsigned)(uintptr_t)shm;
  float*wsf=(float*)(shm+LDS_WS)+wid*64;
  const bf16*ksrc=Kh+(long)lane*DM+wid*8;
  const bf16*vsrc=Vh+(long)(16*(wid&3)+(lane>>2))*DM+(wid>>2)*32+(lane&3)*8;
  const unsigned kdst=lds0+LDS_K+wid*1024, vdst=lds0+LDS_V+wid*1024;
  #define DMA_K(t,slot) glds16(ksrc+(long)(t)*KVBLK*DM,(unsigned)__builtin_amdgcn_readfirstlane(kdst+(slot)))
  #define DMA_V(t,slot) glds16(vsrc+(long)(t)*KVBLK*DM,(unsigned)__builtin_amdgcn_readfirstlane(vdst+(slot)))
  const int vb0=(int)(lds0+LDS_V)+((lane>>4)&1)*32+(lane&3)*8+(4*hi+((lane&15)>>2))*64;
  const char*Kbase=shm+LDS_K; bf16x8 kf[8];
  const lds_cptr shm3=(lds_cptr)shm; const lds_cptr kp0=shm3+LDS_K+hi*1024+r32*16; const lds_cptr vp0=shm3+LDS_V+((lane>>4)&1)*32+(lane&3)*8+(4*hi+((lane&15)>>2))*64;
  const int NT=(q0+QB)/KVBLK;
  DMA_K(0,0);DMA_V(0,0);DMA_K(1,SLOTB);
  unsigned selbits=0u;
  if(qb>0){
    float qf[32];
    #pragma unroll
    for(int c=0;c<4;++c){ const u32x4 w=*reinterpret_cast<const u32x4*>(&Qw[(long)r32*DM+hi*32+c*8]);
      qf[c*8+0]=__uint_as_float(w.x<<16);qf[c*8+1]=__uint_as_float(w.x&0xffff0000u);qf[c*8+2]=__uint_as_float(w.y<<16);qf[c*8+3]=__uint_as_float(w.y&0xffff0000u);
      qf[c*8+4]=__uint_as_float(w.z<<16);qf[c*8+5]=__uint_as_float(w.z&0xffff0000u);qf[c*8+6]=__uint_as_float(w.w<<16);qf[c*8+7]=__uint_as_float(w.w&0xffff0000u); }
    const float*kmb=KM+((long)(b*NHEAD+h)*NQB)*D+hi*32;
    float g0=-3.0e38f,g1=-3.0e38f,g2=-3.0e38f; int s0=-1,s1=-1,s2=-1;
    for(int j=0;j<qb;++j){ const float*km=kmb+j*D; float a=0.f;
      #pragma unroll
      for(int c=0;c<8;++c){ const float4 kv=*reinterpret_cast<const float4*>(km+c*4); a+=qf[c*4]*kv.x; a+=qf[c*4+1]*kv.y; a+=qf[c*4+2]*kv.z; a+=qf[c*4+3]*kv.w; }
      const float gj=a+__shfl_xor(a,32);
      if(gj>g0){g2=g1;s2=s1;g1=g0;s1=s0;g0=gj;s0=j;} else if(gj>g1){g2=g1;s2=s1;g1=gj;s1=j;} else if(gj>g2){g2=gj;s2=j;} }
    if(s0>=0)selbits|=1u<<s0; if(s1>=0)selbits|=1u<<s1; if(s2>=0)selbits|=1u<<s2;
  }
  bf16x8 qr[4];
  #pragma unroll
  for(int d0=0;d0<4;++d0)qr[d0]=*reinterpret_cast<const bf16x8*>(&Qw[(long)r32*DM+d0*16+hi*8]);
  float mhat=0.f,l_reg=0.f;f32x16 o[2];o[0]=f32x16{};o[1]=f32x16{};f32x16 negm=f32x16{};asm volatile("":"+v"(negm));
  const int qrel=wid*QBLK+r32;
  #define SELM(P0,P1,t) do{ if(!((selbits>>((t)>>2))&1u)){ _Pragma("unroll") for(int r=0;r<16;++r){P0[r]=-INFINITY;P1[r]=-INFINITY;} } }while(0)
  #define CMASK(P0,P1,t) do{int jb_=(t)-(NT-4); if(jb_>=0)cmask(P0,P1,jb_,qrel,hi); else SELM(P0,P1,t);}while(0)
  bool resc=false;
  #define START(P0,P1) do{ const float rm=rowmax(P0,P1); resc=false; \
    { const float dl=__builtin_fmaxf(rm,-60.f); mhat=fadd_s(mhat,dl); \
      _Pragma("unroll") for(int r=0;r<16;++r){P0[r]=fsub_s(P0[r],dl);P1[r]=fsub_s(P1[r],dl);} \
      _Pragma("unroll") for(int r=0;r<16;++r)negm[r]=-mhat; asm volatile("":"+v"(negm)); } \
    _Pragma("unroll") for(int r=0;r<16;++r)P0[r]=__builtin_amdgcn_exp2f(P0[r]); }while(0)
  #define RESC() do{ if(resc){ asm volatile("s_waitcnt lgkmcnt(0)":::"memory"); \
      _Pragma("unroll") for(int d_=0;d_<2;++d_) _Pragma("unroll") for(int r=0;r<16;++r)o[d_][r]*=wsf[crow(r,hi)]; } }while(0)
  f32x16 pA0,pA1,pB0,pB1;
  int sl_prev=0,sl_cur=0,sl_next=SLOTB;
  #define ROT() do{sl_prev=sl_cur;sl_cur=sl_next;sl_next=(sl_next==(NSLOT-1)*SLOTB)?0:sl_next+SLOTB;}while(0)
  DMA_K(2,2*SLOTB);
  WAIT_BAR(3);
  qkt(pA0,pA1,Kbase,qr,negm,r32,hi);asm volatile("s_nop 15\n\ts_nop 7":"+v"(pA0),"+v"(pA1));CMASK(pA0,pA1,0);
  START(pA0,pA1);
  _Pragma("unroll") for(int r=0;r<16;++r)pA1[r]=__builtin_amdgcn_exp2f(pA1[r]);
  WAIT_BAR(0);
  DMA_K(3,0);DMA_V(1,SLOTB);
  ROT();
  kload8(kf,kp0+sl_cur);
  WAIT_BAR(2);
  s16x4 vlo[8],vhi[8]; u32x4 pw0,pw1,pw2,pw3;
  #define PKW(P,B) cvtpk_s(P[B],P[B+1])
  #define PAF(k) __builtin_bit_cast(bf16x8,pw##k)
  #define VFR(i) (bf16x8){vlo[i][0],vlo[i][1],vlo[i][2],vlo[i][3],vhi[i][0],vhi[i][1],vhi[i][2],vhi[i][3]}
  #define PIN(x) asm volatile("":"+v"(x))
  #define MX3(a,b,c) __builtin_fmaxf(__builtin_fmaxf((a),(b)),(c))
  #define GAPA(MF,A0,A1,A2,A3,W0,W1,PW) do{ MF; sacc+=A0; sacc+=A1; sacc+=A2; sacc+=A3; PIN(sacc); W0; W1; PIN(PW); SBAR(); }while(0)
  #define EX(v) __builtin_amdgcn_exp2f(v)
  #define GAPB(MF,X,B) do{ MF; X[B]=EX(X[B]); X[B+1]=EX(X[B+1]); X[B+2]=EX(X[B+2]); X[B+3]=EX(X[B+3]); PIN(X); SBAR(); }while(0)
  #define VRD(i) do{ vlo[i]=vtr(vp_+(((i)>>2)*4096+((i)&3)*1024)); vhi[i]=vtr(vp_+(((i)>>2)*4096+((i)&3)*1024+512)); }while(0)
  #define KRD(G,j) do{ if(G){ kload2(kf,kp0+sl_next,j); SBAR(); } }while(0)
  #define STEP(C0,C1,P0,P1,t,GK,GV,GL) do{ SBAR(); \
    const lds_cptr vp_=vp0+sl_prev; \
    VRD(0); SBAR(); float sacc=(P0[0]+P0[1]); \
    GAPA(C0=__builtin_amdgcn_mfma_f32_32x32x16_bf16(kf[0],qr[0],negm,0,0,0), P0[2],P0[3],P0[4],P0[5],     pw0[0]=PKW(P0,0), pw0[1]=PKW(P0,2), pw0); \
    VRD(4); SBAR(); GAPA(C1=__builtin_amdgcn_mfma_f32_32x32x16_bf16(kf[1],qr[0],negm,0,0,0), P0[6],P0[7],P0[8],P0[9],     pw0[2]=PKW(P0,4), pw0[3]=PKW(P0,6), pw0); \
    VRD(1); SBAR(); GAPA(C0=__builtin_amdgcn_mfma_f32_32x32x16_bf16(kf[2],qr[1],C0,0,0,0),   P0[10],P0[11],P0[12],P0[13], pw1[0]=PKW(P0,8), pw1[1]=PKW(P0,10), pw1); \
    VRD(5); SBAR(); GAPA(C1=__builtin_amdgcn_mfma_f32_32x32x16_bf16(kf[3],qr[1],C1,0,0,0),   P0[14],P0[15],P1[0],P1[1],   pw1[2]=PKW(P0,12),pw1[3]=PKW(P0,14), pw1); \
    VRD(2); SBAR(); GAPA(C0=__builtin_amdgcn_mfma_f32_32x32x16_bf16(kf[4],qr[2],C0,0,0,0),   P1[2],P1[3],P1[4],P1[5],     pw2[0]=PKW(P1,0), pw2[1]=PKW(P1,2), pw2); \
    VRD(6); SBAR(); GAPA(C1=__builtin_amdgcn_mfma_f32_32x32x16_bf16(kf[5],qr[2],C1,0,0,0),   P1[6],P1[7],P1[8],P1[9],     pw2[2]=PKW(P1,4), pw2[3]=PKW(P1,6), pw2); \
    VRD(3); SBAR(); GAPA(C0=__builtin_amdgcn_mfma_f32_32x32x16_bf16(kf[6],qr[3],C0,0,0,0),   P1[10],P1[11],P1[12],P1[13], pw3[0]=PKW(P1,8), pw3[1]=PKW(P1,10), pw3); \
    VRD(7); SBAR(); GAPA(C1=__builtin_amdgcn_mfma_f32_32x32x16_bf16(kf[7],qr[3],C1,0,0,0),   P1[14],P1[15],0.f,0.f,       pw3[2]=PKW(P1,12),pw3[3]=PKW(P1,14), pw3); \
    l_reg+=sacc; \
    if(GK){DMA_K((t)+3,sl_cur);} if(GV){DMA_V((t)+1,sl_next);} \
    CMASK(C0,C1,t); \
    { float a=MX3(C0[0],C0[1],C1[0]),b=MX3(C0[2],C0[3],C1[1]); a=MX3(a,C1[2],C1[3]); \
      _Pragma("unroll") for(int r=4;r<16;r+=4){a=MX3(a,C0[r],C0[r+1]);b=MX3(b,C0[r+2],C0[r+3]);a=MX3(a,C1[r],C1[r+1]);b=MX3(b,C1[r+2],C1[r+3]);} \
      float rm=__builtin_fmaxf(a,b); { auto rr=__builtin_amdgcn_permlane32_swap(__float_as_uint(rm),__float_as_uint(rm),false,false); rm=__builtin_fmaxf(__uint_as_float(rr[0]),__uint_as_float(rr[1])); } \
      resc=false; \
      if(__builtin_expect(__any(rm>(float)THRL),0)){ const float dl=__builtin_fmaxf(rm,0.f); mhat+=dl; \
        _Pragma("unroll") for(int r=0;r<16;++r){C0[r]-=dl;C1[r]-=dl;} \
        _Pragma("unroll") for(int r=0;r<16;++r)negm[r]=-mhat; asm volatile("":"+v"(negm)); \
        const float f=__builtin_amdgcn_exp2f(-dl); l_reg*=f; if(hi==0)wsf[r32]=f; resc=true; } } \
    SBAR(); \
    GAPB(o[0]=__builtin_amdgcn_mfma_f32_32x32x16_bf16(PAF(0),VFR(0),o[0],0,0,0), C0,0); \
    GAPB(o[1]=__builtin_amdgcn_mfma_f32_32x32x16_bf16(PAF(0),VFR(4),o[1],0,0,0), C0,4); \
    KRD(GL,0); GAPB(o[0]=__builtin_amdgcn_mfma_f32_32x32x16_bf16(PAF(1),VFR(1),o[0],0,0,0), C0,8); \
    KRD(GL,1); GAPB(o[1]=__builtin_amdgcn_mfma_f32_32x32x16_bf16(PAF(1),VFR(5),o[1],0,0,0), C0,12); \
    KRD(GL,2); GAPB(o[0]=__builtin_amdgcn_mfma_f32_32x32x16_bf16(PAF(2),VFR(2),o[0],0,0,0), C1,0); \
    KRD(GL,3); GAPB(o[1]=__builtin_amdgcn_mfma_f32_32x32x16_bf16(PAF(2),VFR(6),o[1],0,0,0), C1,4); \
    GAPB(o[0]=__builtin_amdgcn_mfma_f32_32x32x16_bf16(PAF(3),VFR(3),o[0],0,0,0), C1,8); \
    GAPB(o[1]=__builtin_amdgcn_mfma_f32_32x32x16_bf16(PAF(3),VFR(7),o[1],0,0,0), C1,12); \
    }while(0)
  int t=1;
  #undef CMASK
  #define CMASK(P0,P1,t) SELM(P0,P1,t)
  for(;t+5<NT;t+=2){
    STEP(pB0,pB1,pA0,pA1,t,true,true,true);     WAIT_BAR(2); RESC(); ROT();
    STEP(pA0,pA1,pB0,pB1,t+1,true,true,true);   WAIT_BAR(2); RESC(); ROT();
  }
  #undef CMASK
  #define CMASK(P0,P1,t) do{int jb_=(t)-(NT-4); if(jb_>=0)cmask(P0,P1,jb_,qrel,hi); else SELM(P0,P1,t);}while(0)
  #define ENDW(tt) do{ if((tt)+3<NT){WAIT_BAR(2);} else if((tt)+2<NT){WAIT_BAR(1);} else {WAIT_BAR(0);} }while(0)
  for(;t+1<NT;t+=2){
    STEP(pB0,pB1,pA0,pA1,t,(t+3<NT),(t+1<NT),(t+1<NT));       ENDW(t);   RESC(); ROT();
    STEP(pA0,pA1,pB0,pB1,t+1,(t+4<NT),(t+2<NT),(t+2<NT));     ENDW(t+1); RESC(); ROT();
  }
  STEP(pB0,pB1,pA0,pA1,NT-1,false,false,false); RESC();
  { float sacc=pB0[0]+pB0[1]; _Pragma("unroll") for(int r=2;r<16;++r)sacc+=pB0[r]; _Pragma("unroll") for(int r=0;r<16;++r)sacc+=pB1[r]; l_reg+=sacc;
    pw0=(u32x4){PKW(pB0,0),PKW(pB0,2),PKW(pB0,4),PKW(pB0,6)};pw1=(u32x4){PKW(pB0,8),PKW(pB0,10),PKW(pB0,12),PKW(pB0,14)};pw2=(u32x4){PKW(pB1,0),PKW(pB1,2),PKW(pB1,4),PKW(pB1,6)};pw3=(u32x4){PKW(pB1,8),PKW(pB1,10),PKW(pB1,12),PKW(pB1,14)};
    SBAR(); pv(o,vb0+sl_cur,PAF(0),PAF(1),PAF(2),PAF(3)); }
  #undef PKW
  #undef PAF
  #undef VFR
  #undef PIN
  #undef MX3
  #undef GAPA
  #undef GAPB
  #undef EX
  #undef VRD
  #undef KRD
  #undef STEP
  #undef ENDW
  {auto rr=__builtin_amdgcn_permlane32_swap(__float_as_uint(l_reg),__float_as_uint(l_reg),false,false);l_reg=__uint_as_float(rr[0])+__uint_as_float(rr[1]);}
  if(hi==0)wsf[32+r32]=l_reg;asm volatile("s_waitcnt lgkmcnt(0)":::"memory");
  float rli[16];
  #pragma unroll
  for(int r=0;r<16;++r)rli[r]=__builtin_amdgcn_rcpf(wsf[32+crow(r,hi)]);
  bf16*Ow=O+(rowbase+q0+wid*QBLK)*YP+YOFF+h*D; const bf16*Gw=SG+(rowbase+q0+wid*QBLK)*DM+h*D;
  { bf16*stg=(bf16*)(shm+LDS_OST)+wid*2048;
    #pragma unroll
    for(int r=0;r<16;++r){const int orow=crow(r,hi);
      #pragma unroll
      for(int d0=0;d0<2;++d0)stg[orow*64+d0*32+r32]=__float2bfloat16(o[d0][r]*rli[r]);}
    asm volatile("s_waitcnt lgkmcnt(0)":::"memory");
    int le=lane; asm volatile("":"+v"(le));
    #pragma unroll
    for(int i=0;i<4;++i){const int row=i*8+(le>>3),ch=le&7; const u32x4 v=*(const u32x4*)(stg+row*64+ch*8); const u32x4 g=*(const u32x4*)(Gw+(row*DM+ch*8)); u32x4 w;
      w.x=cvtpk_s(__uint_as_float(v.x<<16)*__uint_as_float(g.x<<16),__uint_as_float(v.x&0xffff0000u)*__uint_as_float(g.x&0xffff0000u));
      w.y=cvtpk_s(__uint_as_float(v.y<<16)*__uint_as_float(g.y<<16),__uint_as_float(v.y&0xffff0000u)*__uint_as_float(g.y&0xffff0000u));
      w.z=cvtpk_s(__uint_as_float(v.z<<16)*__uint_as_float(g.z<<16),__uint_as_float(v.z&0xffff0000u)*__uint_as_float(g.z&0xffff0000u));
      w.w=cvtpk_s(__uint_as_float(v.w<<16)*__uint_as_float(g.w<<16),__uint_as_float(v.w&0xffff0000u)*__uint_as_float(g.w&0xffff0000u));
      ATTN_STORE16(Ow+(row*YP+ch*8),w);} }
  asm volatile("s_waitcnt lgkmcnt(0)\n\ts_barrier":::"memory");
  #undef DMA_K
  #undef DMA_V
  #undef CMASK
  #undef SELM
  #undef START
  #undef RESC
  #undef ROT
}
constexpr int ATTN_LDS_BYTES=LDS_BYTES;
struct AttnTensors { const bf16* Q; const bf16* K; const bf16* V; bf16* O; const bf16* SG; const float* KM; };
struct AttnUnit { int bh; int qb; };
struct StaticOrder {
  int vcu;
  __device__ __forceinline__ explicit StaticOrder(int grid,int block):vcu((block%8)*(grid/8)+block/8){}
  __device__ __forceinline__ bool next(int i,AttnUnit&u)const{ if(i>=4)return false; const int s=vcu&3; u.bh=vcu>>2; u.qb=(i==0)?15-s:(i==1)?8+s:(i==2)?7-s:s; return true; }
  __device__ __forceinline__ void a_ready(const AttnUnit&)const{}
  __device__ __forceinline__ void done(const AttnUnit&)const{}
};
template<class Sched,int THRL=8> __device__ __forceinline__ void attn_phase(char*lds,const AttnTensors&T,const Sched&S,int wave_s){
  AttnUnit u;
  for(int i=0;S.next(i,u);++i){ S.a_ready(u); attn_unit<THRL>(u.bh/NHEAD,u.bh%NHEAD,u.qb,T.Q,T.K,T.V,T.O,T.SG,T.KM,lds,wave_s); S.done(u); }
}
#undef SBAR
#undef WAIT_BAR
}

struct Args { const void* in[15]; float* out; unsigned char* ws; int ph_lo, ph_hi; };
constexpr int NPH = 7;

__global__ void __launch_bounds__(512, 2) mk_fwd(Args args) {
    extern __shared__ __attribute__((aligned(16))) unsigned char lds[];
    Frame F;
    F.lds = lds; F.tid = threadIdx.x; F.lane = F.tid & 63; F.wave = __builtin_amdgcn_readfirstlane(F.tid >> 6);
    F.G = gridDim.x; { const int bx = blockIdx.x; F.vcu = (F.G % 8 == 0) ? (bx % 8) * (F.G / 8) + bx / 8 : bx; }
    F.x = (const float*)args.in[0]; F.c = (const float*)args.in[1]; F.pos = (const int*)args.in[2]; F.w_ada = (const float*)args.in[3]; F.b_ada = (const float*)args.in[4];
    F.g_norm = (const float*)args.in[5]; F.w_in = (const float*)args.in[6]; F.w_dw = (const float*)args.in[7]; F.b_dw = (const float*)args.in[8];
    F.g_ln = (const float*)args.in[9]; F.b_ln = (const float*)args.in[10]; F.w_pw = (const float*)args.in[11]; F.b_pw = (const float*)args.in[12];
    F.w_out = (const float*)args.in[13]; F.g_final = (const float*)args.in[14];
    F.out = args.out; F.ws = args.ws;
    const int lo = args.ph_lo, hi = args.ph_hi;
#define IN(k) (lo <= (k) && (k) < hi)
#define SEAM(k) do { if (IN(k) && IN((k) + 1)) cg::this_grid().sync(); } while (0)
    PG8_LAS unsigned char* ldsl = (PG8_LAS unsigned char*)lds;
    if (IN(0)) { p0_mod(F); p0_rope(F); p0_weights(F); }
    SEAM(0);
    if (IN(1)) p1_h(F);
    SEAM(1);
    if (IN(2)) {
        pg8::Gemm g{(const bf16*)(F.ws + WS_H), (const bf16*)(F.ws + WS_WIN), T_, DIN, D_}; pg8::StaticOrder S; S.init(T_, DIN, F.G, (int)blockIdx.x);
        EpiProj E{(bf16*)(F.ws + WS_U), (bf16*)(F.ws + WS_SGC), (bf16*)(F.ws + WS_Q), (bf16*)(F.ws + WS_K), (bf16*)(F.ws + WS_V), (bf16*)(F.ws + WS_SGA), (const float*)(F.ws + WS_ROPE), (float*)(F.ws + WS_KMEAN)};
        pg8::gemm_phase<EpiProj, pg8::StaticOrder, true, true>(ldsl, g, S, E, F.wave);
    }
    SEAM(2);
    if (IN(3)) {
        n3_conv(F);
        __syncthreads();
        const attn_body::AttnTensors AT{(const attn_body::bf16*)(F.ws + WS_Q), (const attn_body::bf16*)(F.ws + WS_K), (const attn_body::bf16*)(F.ws + WS_V), (attn_body::bf16*)(F.ws + WS_YCAT),
                                        (const attn_body::bf16*)(F.ws + WS_SGA), (const float*)(F.ws + WS_KMEAN)};
        const attn_body::StaticOrder S((int)F.G, (int)blockIdx.x);
        attn_body::attn_phase<attn_body::StaticOrder>((char*)lds, AT, S, F.wave);
    }
    SEAM(3);
    F.lane = mk_lane(); F.tid = F.wave * 64 + F.lane;
    if (IN(4)) {
        pg8::Gemm g{(const bf16*)(F.ws + WS_ALN), (const bf16*)(F.ws + WS_WPW), T_, DC, DC}; pg8::StaticOrder S; S.init(T_, DC, F.G, (int)blockIdx.x);
        EpiPw E{(bf16*)(F.ws + WS_YCAT), (const bf16*)(F.ws + WS_SGC), F.b_pw};
        pg8::gemm_phase<EpiPw, pg8::StaticOrder, true, true>(ldsl, g, S, E, F.wave);
    }
    SEAM(4);
    if (IN(5)) {
        pg8::Gemm g{(const bf16*)(F.ws + WS_YCAT), (const bf16*)(F.ws + WS_WOUT), T_, D_, D_}; pg8::StaticOrder S; S.init(T_, D_, F.G, (int)blockIdx.x);
        EpiOut E{F.out, F.x, (const float*)(F.ws + WS_MOD)};
        pg8::gemm_phase<EpiOut, pg8::StaticOrder, true, true>(ldsl, g, S, E, F.wave);
    }
    SEAM(5);
    if (IN(6)) p6_final(F);
#undef IN
#undef SEAM
}

extern "C" void kernel_launch(void* const* d_in, const int* in_sizes, int n_in, void* d_out, int out_size, void* d_ws, size_t ws_size, hipStream_t stream) {
    static int grid = 0;
    if (grid == 0) {
        if (n_in != 15 || out_size != T_ * D_ || ws_size < WS_END) { fprintf(stderr, "kernel_launch: unexpected problem (n_in %d out %d ws %zu)\n", n_in, out_size, ws_size); grid = -1; return; }
        int dev = 0, cus = 0, per_cu = 0;
        hipGetDevice(&dev); hipDeviceGetAttribute(&cus, hipDeviceAttributeMultiprocessorCount, dev);
        hipFuncSetAttribute((const void*)mk_fwd, hipFuncAttributeMaxDynamicSharedMemorySize, LDS_BYTES);
        hipOccupancyMaxActiveBlocksPerMultiprocessor(&per_cu, (const void*)mk_fwd, 512, LDS_BYTES);
        if (per_cu < 1) per_cu = 1;
        (void)hipGetLastError();
        grid = cus * per_cu;
    }
    if (grid < 0) return;
    hipMemsetAsync((char*)d_ws + WS_CTL, 0, CTL_ZERO, stream);
    Args a{};
    for (int i = 0; i < 15; ++i) a.in[i] = d_in[i];
    a.out = (float*)d_out; a.ws = (unsigned char*)d_ws;
    a.ph_lo = 0; a.ph_hi = NPH;
    void* kargs[] = {&a};
    hipError_t e = hipLaunchCooperativeKernel((const void*)mk_fwd, dim3(grid), dim3(512), kargs, LDS_BYTES, stream);
    if (e != hipSuccess) fprintf(stderr, "cooperative launch failed: %s (grid %d)\n", hipGetErrorString(e), grid);
}
```

```cpp
#include <hip/hip_runtime.h>
#include <hip/hip_cooperative_groups.h>
#include <cstdio>
#include <cstdint>
namespace cg = cooperative_groups;

constexpr int NB_ = 8, S_ = 4096, T_ = NB_ * S_, D_ = 1024, DIN = 3584, DC = 512, NH = 8, HD = 64, KB = 256, NKB = S_ / KB, CW = 31;
constexpr float EPS_ = 1e-6f;
constexpr float C2 = 0.125f * 1.4426950408889634f;

typedef unsigned short bf16;
typedef unsigned u32x4 __attribute__((ext_vector_type(4)));
typedef float f32x4 __attribute__((ext_vector_type(4)));

constexpr size_t MiB = 1u << 20;
constexpr size_t WS_CTL = 0;
constexpr size_t CTL_ZERO = 2 * MiB;
constexpr size_t WS_KMEAN = 1 * MiB;
constexpr size_t WS_MODP = 2 * MiB;
constexpr size_t WS_MOD = 2 * MiB + 512 * 1024;
constexpr size_t WS_ROPE = 3 * MiB;
constexpr size_t WS_WIN = 6 * MiB;
constexpr size_t WS_WPW = 13 * MiB;
constexpr size_t WS_WOUT = 14 * MiB;
constexpr size_t WS_H = 16 * MiB;
constexpr size_t WS_U = 80 * MiB;
constexpr size_t WS_SGC = 112 * MiB;
constexpr size_t WS_Q = 144 * MiB;
constexpr size_t WS_K = 176 * MiB;
constexpr size_t WS_V = 208 * MiB;
constexpr size_t WS_SGA = 240 * MiB;
constexpr size_t WS_ALN = 272 * MiB;
constexpr size_t WS_YCAT = 304 * MiB;
constexpr size_t WS_P = 272 * MiB;
constexpr size_t WS_END = 496 * MiB;

constexpr int LDS_BYTES = 147456;

__device__ __forceinline__ float bf2f(unsigned b) { return __uint_as_float(b << 16); }
__device__ __forceinline__ unsigned f2bf(float f) { unsigned u = __float_as_uint(f); return (u + 0x7fffu + ((u >> 16) & 1u)) >> 16; }
__device__ __forceinline__ unsigned pk2(float lo, float hi) { return f2bf(lo) | (f2bf(hi) << 16); }
__device__ __forceinline__ float silu_f(float v) { return v / (1.f + __expf(-v)); }
__device__ __forceinline__ float sigm_f(float v) { return 1.f / (1.f + __expf(-v)); }
__device__ __forceinline__ float wave_sum(float v) {
#pragma unroll
    for (int o = 1; o < 64; o <<= 1) v += __shfl_xor(v, o);
    return v;
}
__device__ __forceinline__ float wave_max(float v) {
#pragma unroll
    for (int o = 1; o < 64; o <<= 1) v = fmaxf(v, __shfl_xor(v, o));
    return v;
}
__device__ __forceinline__ void unpack8(const u32x4 v, float (&f)[8]) {
    f[0] = bf2f(v.x & 0xffffu); f[1] = bf2f(v.x >> 16); f[2] = bf2f(v.y & 0xffffu); f[3] = bf2f(v.y >> 16);
    f[4] = bf2f(v.z & 0xffffu); f[5] = bf2f(v.z >> 16); f[6] = bf2f(v.w & 0xffffu); f[7] = bf2f(v.w >> 16);
}
__device__ __forceinline__ u32x4 pack8(const float (&f)[8]) {
    u32x4 o; o.x = pk2(f[0], f[1]); o.y = pk2(f[2], f[3]); o.z = pk2(f[4], f[5]); o.w = pk2(f[6], f[7]); return o;
}

struct Frame {
    unsigned char* lds;
    int tid, lane, wave, vcu, G;
    const float *x, *c, *w_ada, *b_ada, *g_norm, *w_in, *w_dw, *b_dw, *g_ln, *b_ln, *w_pw, *b_pw, *w_out, *g_final;
    const int* pos;
    float* out; unsigned char* ws;
};

__device__ __forceinline__ int mk_lane() { int l = (int)__builtin_amdgcn_mbcnt_hi(~0u, __builtin_amdgcn_mbcnt_lo(~0u, 0u)); asm volatile("" : "+v"(l)); return l; }
namespace pg8 {
#define PG8_LAS __attribute__((address_space(3)))
typedef unsigned short bf16_t;
typedef short bf16x8 __attribute__((ext_vector_type(8)));
typedef float f32x4 __attribute__((ext_vector_type(4)));
typedef unsigned u32x4 __attribute__((ext_vector_type(4)));
constexpr int BM = 256, BK = 64, HALF = 128, HTB = HALF * BK * 2  , STAGE_BYTES = 8 * HTB, NXCD = 8, WGM = 8;

__host__ __device__ __forceinline__ int lds_byte(int r, int c) { const int st = (r >> 4) * 2 + (c >> 5), rr = r & 15, cc = c & 31, ob = rr * 64 + cc * 2; return st * 1024 + (ob ^ (((ob >> 9) & 1) << 5)); }
__host__ __device__ __forceinline__ void stage_rc(int b, int& R, int& C) { const int st = b / 1024, sb = b % 1024, swz = sb ^ (((sb >> 9) & 1) << 5); R = (st >> 1) * 16 + swz / 64; C = (st & 1) * 32 + (swz % 64) / 2; }
__host__ __device__ __forceinline__ int perm32(int rho) { const int n = rho >> 4, i = rho & 15; return 8 * (i >> 2) + 4 * n + (i & 3); }

struct Unit { int pm, pn; };
struct Gemm { const bf16_t* A; const bf16_t* Bt; int M, N, K; };

struct StaticOrder {
    int nM, nN, nwg, G, c;
    __host__ __device__ void init(int M, int N, int G_, int c_) { nM = M / BM; nN = N / BM; nwg = nM * nN; G = G_; c = c_; }
    __host__ __device__ bool next(int i, Unit& u) const {
        const long L = (long)i * G + c; if (L >= nwg) return false;
        int wgid = (int)L; { const int q = nwg / NXCD, r = nwg % NXCD, xcd = wgid % NXCD, off = wgid / NXCD; wgid = (xcd < r ? xcd * (q + 1) : r * (q + 1) + (xcd - r) * q) + off; }
        const int nig = WGM * nN, gid = wgid / nig, fm = gid * WGM, gsz = (nM - fm) < WGM ? (nM - fm) : WGM;
        u.pm = fm + ((wgid % nig) % gsz); u.pn = (wgid % nig) / gsz; return true;
    }
    __device__ __forceinline__ void a_ready(const Unit&) const {}
    __device__ __forceinline__ void done(const Unit&) const {}
};

__device__ __forceinline__ unsigned cvt_pk_bf16(float lo, float hi) { unsigned r; asm volatile("v_cvt_pk_bf16_f32 %0, %1, %2" : "=v"(r) : "v"(lo), "v"(hi)); return r; }
typedef float f32x2 __attribute__((ext_vector_type(2)));
template <class Epi, class Sched, bool ALIGN_EPI = false, bool SP2 = false>
__device__ __forceinline__ void gemm_phase(PG8_LAS unsigned char* lds, const Gemm g, const Sched& S, const Epi& E, int wave_s) {
    const int lane = mk_lane(), wid = __builtin_amdgcn_readfirstlane(wave_s), tid = wid * 64 + lane, wr = wid >> 2, wc = wid & 3, fr = lane & 15, fq = lane >> 4;
    const int K = g.K, nt = K / BK;
    unsigned voffA[2], voffB[2];
#pragma unroll
    for (int i = 0; i < 2; ++i) { int R, C; stage_rc(tid * 16 + i * 8192, R, C); const int Rb = Epi::PERM ? ((R & ~31) + perm32(R & 31)) : R;
        voffA[i] = (unsigned)(R * K + C) * 2u; voffB[i] = (unsigned)(Rb * K + C) * 2u; }
    const size_t kstep = (size_t)(BK * 2);
    const size_t hstep = (size_t)HALF * K * 2;
    const size_t tstep = 2 * hstep;
    const unsigned ldsw = (unsigned)wid * 1024u;
    const int aoff = lds_byte(wr * 64 + fr, fq * 8), boff = lds_byte(wc * 32 + fr, fq * 8);
#define PG8_SA(b, h) (((b) * 2 + (h)) * HTB)
#define PG8_SB(b, h) ((4 + (b) * 2 + (h)) * HTB)
#define PG8_STAGE(bufoff, gbase, voff) do { _Pragma("unroll") for (int _i = 0; _i < 2; ++_i) \
        __builtin_amdgcn_global_load_lds((const unsigned*)((const char*)(gbase) + (voff)[_i]), (PG8_LAS unsigned*)(lds + (bufoff) + ldsw + _i * 8192), 16, 0, 0); } while (0)
#define PG8_LDA(dst, b, h) do { _Pragma("unroll") for (int m = 0; m < 4; ++m) _Pragma("unroll") for (int k = 0; k < 2; ++k) dst[m][k] = *(const PG8_LAS bf16x8*)(lds + PG8_SA(b, h) + aoff + m * 2048 + k * 1024); } while (0)
#define PG8_LDB(dst, b, h) do { _Pragma("unroll") for (int n = 0; n < 2; ++n) _Pragma("unroll") for (int k = 0; k < 2; ++k) dst[n][k] = *(const PG8_LAS bf16x8*)(lds + PG8_SB(b, h) + boff + n * 2048 + k * 1024); } while (0)
#define PG8_MMA(ai, bj, At, Bt) do { __builtin_amdgcn_s_setprio(1); _Pragma("unroll") for (int m = 0; m < 4; ++m) _Pragma("unroll") for (int n = 0; n < 2; ++n) _Pragma("unroll") for (int k = 0; k < 2; ++k) \
        acc[ai][bj][m][n] = __builtin_amdgcn_mfma_f32_16x16x32_bf16(Bt[n][k], At[m][k], acc[ai][bj][m][n], 0, 0, 0); __builtin_amdgcn_s_setprio(0); } while (0)
#define PG8_WAIT_V(n) asm volatile("s_waitcnt vmcnt(" #n ")" ::: "memory")
#define PG8_WAIT_L(n) asm volatile("s_waitcnt lgkmcnt(" #n ")" ::: "memory")
#define PG8_BAR __builtin_amdgcn_s_barrier()
#define PG8_SCHED __builtin_amdgcn_sched_barrier(0)
    Unit cur, nxt; int ui = 0;
    if (!S.next(0, cur)) return;
    f32x4 acc[2][2][4][2];
#pragma unroll
    for (int a = 0; a < 2; ++a)
#pragma unroll
        for (int b = 0; b < 2; ++b)
#pragma unroll
            for (int m = 0; m < 4; ++m)
#pragma unroll
                for (int n = 0; n < 2; ++n) acc[a][b][m][n] = (f32x4){0.f, 0.f, 0.f, 0.f};
    bf16x8 At[4][2], B0[2][2], B1[2][2];
    const char* cA = (const char*)g.A + (size_t)cur.pm * tstep; const char* cB = (const char*)g.Bt + (size_t)cur.pn * tstep;
    S.a_ready(cur);
    if constexpr (SP2) {
        PG8_STAGE(PG8_SB(0, 0), cB, voffB); PG8_STAGE(PG8_SB(0, 1), cB + hstep, voffB); PG8_STAGE(PG8_SA(0, 0), cA, voffA); PG8_STAGE(PG8_SA(0, 1), cA + hstep, voffA);
        if (wr == 1) PG8_BAR;
        PG8_WAIT_V(2); PG8_BAR;
        PG8_STAGE(PG8_SB(1, 0), cB + kstep, voffB); PG8_STAGE(PG8_SA(1, 0), cA + kstep, voffA); PG8_STAGE(PG8_SB(1, 1), cB + hstep + kstep, voffB);
        PG8_WAIT_V(6); PG8_BAR;
    } else {
        PG8_STAGE(PG8_SB(0, 0), cB, voffB); PG8_STAGE(PG8_SA(0, 0), cA, voffA); PG8_STAGE(PG8_SB(0, 1), cB + hstep, voffB); PG8_STAGE(PG8_SA(0, 1), cA + hstep, voffA);
        if (wr == 1) PG8_BAR;
        PG8_WAIT_V(4); PG8_BAR;
        PG8_STAGE(PG8_SB(1, 0), cB + kstep, voffB); PG8_STAGE(PG8_SA(1, 0), cA + kstep, voffA); PG8_STAGE(PG8_SB(1, 1), cB + hstep + kstep, voffB);
        PG8_WAIT_V(6); PG8_BAR;
    }
    for (;;) {
        const bool has_next = S.next(ui + 1, nxt);
        const char* nA = has_next ? (const char*)g.A + (size_t)nxt.pm * tstep : cA; const char* nB = has_next ? (const char*)g.Bt + (size_t)nxt.pn * tstep : cB;
        for (int t = 0; t < nt; t += 2) {
            const bool last = (t == nt - 2);
            const char* a1 = cA + (size_t)(t + 1) * kstep;
            const char* a2 = last ? nA : cA + (size_t)(t + 2) * kstep; const char* b2 = last ? nB : cB + (size_t)(t + 2) * kstep;
            const char* a3 = a2 + kstep; const char* b3 = b2 + kstep;
            if (last && has_next) S.a_ready(nxt);
            if constexpr (SP2) {
            PG8_LDB(B0, 0, 0); PG8_LDB(B1, 0, 1); PG8_SCHED; PG8_LDA(At, 0, 0); PG8_STAGE(PG8_SA(1, 1), a1 + hstep, voffA);
            PG8_WAIT_V(8); PG8_WAIT_L(0); PG8_BAR; PG8_MMA(0, 0, At, B0); PG8_MMA(0, 1, At, B1); PG8_BAR; PG8_SCHED;
            PG8_LDA(At, 0, 1); PG8_STAGE(PG8_SB(0, 0), b2, voffB); PG8_STAGE(PG8_SB(0, 1), b2 + hstep, voffB); PG8_STAGE(PG8_SA(0, 0), a2, voffA);
            PG8_WAIT_V(8); PG8_WAIT_L(0); PG8_BAR; PG8_MMA(1, 0, At, B0); PG8_MMA(1, 1, At, B1); PG8_BAR; PG8_SCHED;
            PG8_LDB(B0, 1, 0); PG8_LDB(B1, 1, 1); PG8_SCHED; PG8_LDA(At, 1, 0); PG8_STAGE(PG8_SA(0, 1), a2 + hstep, voffA);
            PG8_WAIT_V(8); PG8_WAIT_L(0); PG8_BAR; PG8_MMA(0, 0, At, B0); PG8_MMA(0, 1, At, B1); PG8_BAR; PG8_SCHED;
            PG8_LDA(At, 1, 1); PG8_STAGE(PG8_SB(1, 0), b3, voffB); PG8_STAGE(PG8_SB(1, 1), b3 + hstep, voffB); PG8_STAGE(PG8_SA(1, 0), a3, voffA);
            PG8_WAIT_V(8); PG8_WAIT_L(0); PG8_BAR; PG8_MMA(1, 0, At, B0); PG8_MMA(1, 1, At, B1); PG8_BAR; PG8_SCHED;
            } else {
            PG8_LDB(B0, 0, 0); PG8_SCHED; PG8_LDA(At, 0, 0); PG8_STAGE(PG8_SA(1, 1), a1 + hstep, voffA);
            PG8_WAIT_L(8); PG8_BAR; PG8_WAIT_L(0); PG8_MMA(0, 0, At, B0); PG8_BAR; PG8_SCHED;
            PG8_LDB(B1, 0, 1); PG8_STAGE(PG8_SB(0, 0), b2, voffB);
            PG8_BAR; PG8_WAIT_L(0); PG8_MMA(0, 1, At, B1); PG8_BAR;
            PG8_LDA(At, 0, 1); PG8_STAGE(PG8_SA(0, 0), a2, voffA);
            PG8_BAR; PG8_WAIT_L(0); PG8_MMA(1, 0, At, B0); PG8_BAR; PG8_SCHED;
            PG8_STAGE(PG8_SB(0, 1), b2 + hstep, voffB);
            PG8_WAIT_V(6); PG8_BAR; PG8_MMA(1, 1, At, B1); PG8_BAR;
            PG8_LDB(B0, 1, 0); PG8_SCHED; PG8_LDA(At, 1, 0); PG8_STAGE(PG8_SA(0, 1), a2 + hstep, voffA);
            PG8_WAIT_L(8); PG8_BAR; PG8_WAIT_L(0); PG8_MMA(0, 0, At, B0); PG8_BAR; PG8_SCHED;
            PG8_LDB(B1, 1, 1); PG8_STAGE(PG8_SB(1, 0), b3, voffB);
            PG8_BAR; PG8_WAIT_L(0); PG8_MMA(0, 1, At, B1); PG8_BAR;
            PG8_LDA(At, 1, 1); PG8_STAGE(PG8_SA(1, 0), a3, voffA);
            PG8_BAR; PG8_WAIT_L(0); PG8_MMA(1, 0, At, B0); PG8_BAR; PG8_SCHED;
            PG8_STAGE(PG8_SB(1, 1), b3 + hstep, voffB);
            PG8_WAIT_V(6); PG8_BAR; PG8_MMA(1, 1, At, B1); PG8_BAR;
            }
        }
        if constexpr (ALIGN_EPI) { if (wr == 0) PG8_BAR; }
        if constexpr (!Epi::AFTER_DRAIN) { E(acc, cur, wr, wc, fr, fq); S.done(cur); }
        if (!has_next) break;
#pragma unroll
        for (int a = 0; a < 2; ++a)
#pragma unroll
            for (int b = 0; b < 2; ++b)
#pragma unroll
                for (int m = 0; m < 4; ++m)
#pragma unroll
                    for (int n = 0; n < 2; ++n) acc[a][b][m][n] = (f32x4){0.f, 0.f, 0.f, 0.f};
        cur = nxt; cA = nA; cB = nB; ++ui;
        if constexpr (ALIGN_EPI) { if (wr == 1) PG8_BAR; }
    }
    PG8_WAIT_V(0);
    if constexpr (!ALIGN_EPI) { if (wr == 0) PG8_BAR; }
    PG8_BAR;
    if constexpr (Epi::AFTER_DRAIN) { E.fused(acc, cur, wr, wc, fr, fq, lds, wid, lane); S.done(cur); }
#undef PG8_SA
#undef PG8_SB
#undef PG8_STAGE
#undef PG8_LDA
#undef PG8_LDB
#undef PG8_MMA
#undef PG8_WAIT_V
#undef PG8_WAIT_L
#undef PG8_BAR
#undef PG8_SCHED
}
}

__device__ __forceinline__ int colmap_in(int n) {
    const int tile = n >> 8, w = n & 255;
    if (tile < 4) return ((w >> 7) ? 512 : 0) + tile * 128 + (w & 127);
    if (tile >= 6 && tile < 10) { const int vd = n & 63; if (vd < 16) { const int g = vd >> 3, e = vd & 7; return (n & ~63) + ((e < 4) ? 4 * g + e : 8 + 4 * g + (e - 4)); } }
    return n;
}
__device__ __forceinline__ u32x4 pack2v(const f32x4 a, const f32x4 b) { u32x4 w; w.x = pg8::cvt_pk_bf16(a[0], a[1]); w.y = pg8::cvt_pk_bf16(a[2], a[3]); w.z = pg8::cvt_pk_bf16(b[0], b[1]); w.w = pg8::cvt_pk_bf16(b[2], b[3]); return w; }
__device__ __forceinline__ f32x4 sigm4(const f32x4 g) { f32x4 r; r.x = sigm_f(g.x); r.y = sigm_f(g.y); r.z = sigm_f(g.z); r.w = sigm_f(g.w); return r; }
struct EpiProj {
    static constexpr bool PERM = true, AFTER_DRAIN = false;
    bf16 *U, *SGC, *Q, *K, *V, *SGA; const float* ROPE; float* KM;
    __device__ __forceinline__ void operator()(const f32x4 (&acc)[2][2][4][2], const pg8::Unit& u, int wr, int wc, int fr, int fq) const {
        const int row0 = u.pm * 256 + wr * 64 + fr, colw = wc * 32 + 8 * fq, pn = u.pn;
        if (pn < 4) {
#pragma unroll
            for (int ai = 0; ai < 2; ++ai)
#pragma unroll
                for (int m = 0; m < 4; ++m) { const int row = row0 + ai * 128 + m * 16;
                    const f32x4 o0 = acc[ai][0][m][0] * sigm4(acc[ai][1][m][0]), o1 = acc[ai][0][m][1] * sigm4(acc[ai][1][m][1]);
                    *(u32x4*)(U + (size_t)row * DC + pn * 128 + colw) = pack2v(o0, o1); }
            return;
        }
        const int sec = (pn - 4) >> 1, cb = ((pn - 4) & 1) * 256;
        bf16* base = (sec == 0) ? SGC : (sec == 1) ? Q : (sec == 2) ? K : (sec == 3) ? V : SGA;
        const bool is_qk = (sec == 1 || sec == 2), rope_w = is_qk && !(wc & 1), rope_l = rope_w && fq < 2;
        f32x4 ks[2][2];
#pragma unroll
        for (int bj = 0; bj < 2; ++bj) { ks[bj][0] = (f32x4){0.f, 0.f, 0.f, 0.f}; ks[bj][1] = (f32x4){0.f, 0.f, 0.f, 0.f}; }
#pragma unroll
        for (int ai = 0; ai < 2; ++ai)
#pragma unroll
            for (int m = 0; m < 4; ++m) { const int row = row0 + ai * 128 + m * 16;
                f32x4 cs0 = (f32x4){1.f, 0.f, 1.f, 0.f}, cs1 = cs0;
                if (rope_w) { const f32x4* rp = (const f32x4*)(ROPE + ((size_t)row * 8 + 4 * (fq & 1)) * 2); cs0 = rp[0]; cs1 = rp[1]; }
#pragma unroll
                for (int bj = 0; bj < 2; ++bj) { f32x4 v0 = acc[ai][bj][m][0], v1 = acc[ai][bj][m][1];
                    if (sec == 0 || sec == 4) { v0 = v0 * sigm4(v0); v1 = v1 * sigm4(v1); }
                    else if (is_qk) {
                        if (rope_w) { const f32x4 co = (f32x4){cs0.x, cs0.z, cs1.x, cs1.z}, si = (f32x4){cs0.y, cs0.w, cs1.y, cs1.w};
                            const f32x4 r1 = v0 * co - v1 * si, r2 = v1 * co + v0 * si;
                            if (rope_l) { v0 = r1; v1 = r2; } }
                        if (sec == 1) { v0 = v0 * C2; v1 = v1 * C2; } else { ks[bj][0] += v0; ks[bj][1] += v1; }
                    }
                    *(u32x4*)(base + (size_t)row * DC + cb + bj * 128 + colw) = pack2v(v0, v1); } }
        if (sec == 2) {
            const int b = u.pm >> 4, blk = u.pm & 15;
#pragma unroll
            for (int bj = 0; bj < 2; ++bj)
#pragma unroll
                for (int n = 0; n < 2; ++n)
#pragma unroll
                    for (int e = 0; e < 4; ++e) { float s = ks[bj][n][e];
                        s += __shfl_xor(s, 1); s += __shfl_xor(s, 2); s += __shfl_xor(s, 4); s += __shfl_xor(s, 8);
                        if (fr == 0) { const int kc = cb + bj * 128 + colw + 4 * n + e; atomicAdd(KM + (((size_t)b * NH + (kc >> 6)) * NKB + blk) * HD + (kc & 63), s * (1.f / KB)); } }
        }
    }
};
struct EpiPw {
    static constexpr bool PERM = true, AFTER_DRAIN = false;
    bf16* Y; const bf16* SGC; const float* bias;
    __device__ __forceinline__ void operator()(const f32x4 (&acc)[2][2][4][2], const pg8::Unit& u, int wr, int wc, int fr, int fq) const {
        const int row0 = u.pm * 256 + wr * 64 + fr, col0 = u.pn * 256 + wc * 32 + 8 * fq;
        f32x4 bv[2][2];
#pragma unroll
        for (int bj = 0; bj < 2; ++bj) { bv[bj][0] = *(const f32x4*)(bias + col0 + bj * 128); bv[bj][1] = *(const f32x4*)(bias + col0 + bj * 128 + 4); }
#pragma unroll
        for (int ai = 0; ai < 2; ++ai)
#pragma unroll
            for (int m = 0; m < 4; ++m) { const int row = row0 + ai * 128 + m * 16;
#pragma unroll
                for (int bj = 0; bj < 2; ++bj) { float g[8]; unpack8(*(const u32x4*)(SGC + (size_t)row * DC + col0 + bj * 128), g);
                    const f32x4 v0 = (acc[ai][bj][m][0] + bv[bj][0]) * (f32x4){g[0], g[1], g[2], g[3]}, v1 = (acc[ai][bj][m][1] + bv[bj][1]) * (f32x4){g[4], g[5], g[6], g[7]};
                    *(u32x4*)(Y + (size_t)row * D_ + col0 + bj * 128) = pack2v(v0, v1); } }
    }
};
struct EpiOut {
    static constexpr bool PERM = false, AFTER_DRAIN = false;
    float* O; const float* x; const float* MOD;
    __device__ __forceinline__ void operator()(const f32x4 (&acc)[2][2][4][2], const pg8::Unit& u, int wr, int wc, int fr, int fq) const {
        const int row0 = u.pm * 256 + wr * 64 + fr, col0 = u.pn * 256 + wc * 32 + 4 * fq, b = u.pm >> 4;
        f32x4 gv[2][2];
#pragma unroll
        for (int bj = 0; bj < 2; ++bj)
#pragma unroll
            for (int n = 0; n < 2; ++n) gv[bj][n] = *(const f32x4*)(MOD + (size_t)b * 3072 + 2048 + col0 + bj * 128 + n * 16);
#pragma unroll
        for (int ai = 0; ai < 2; ++ai)
#pragma unroll
            for (int m = 0; m < 4; ++m) { const size_t off = (size_t)(row0 + ai * 128 + m * 16) * D_ + col0;
#pragma unroll
                for (int bj = 0; bj < 2; ++bj)
#pragma unroll
                    for (int n = 0; n < 2; ++n) { const f32x4 xv = *(const f32x4*)(x + off + bj * 128 + n * 16);
                        *(f32x4*)(O + off + bj * 128 + n * 16) = xv + gv[bj][n] * acc[ai][bj][m][n]; } }
    }
};

template <bool MAP>
__device__ __forceinline__ void p0_transpose_item(const float* W, int K, int N, bf16* WT, float* scr, int item, int lane) {
    const int nblk = N / 32, kb = item / nblk, nb = item % nblk, k0 = 64 * kb, n0 = 32 * nb;
    const int ncol = MAP ? colmap_in(n0 + (lane & 31)) : n0 + (lane & 31);
#pragma unroll 8
    for (int i = 0; i < 32; ++i) { const int kk = 2 * i + (lane >> 5); scr[kk * 33 + (lane & 31)] = W[(size_t)(k0 + kk) * N + ncol]; }
    __builtin_amdgcn_s_waitcnt(0); __builtin_amdgcn_wave_barrier();
    const int c = lane & 7;
#pragma unroll
    for (int j = 0; j < 4; ++j) { const int n = (lane >> 3) + 8 * j; const float* s = scr + (8 * c) * 33 + n;
        u32x4 o; o.x = pk2(s[0 * 33], s[1 * 33]); o.y = pk2(s[2 * 33], s[3 * 33]); o.z = pk2(s[4 * 33], s[5 * 33]); o.w = pk2(s[6 * 33], s[7 * 33]);
        *(u32x4*)(WT + (size_t)(n0 + n) * K + k0 + 8 * c) = o; }
    __builtin_amdgcn_s_waitcnt(0); __builtin_amdgcn_wave_barrier();
}

__device__ __forceinline__ void p0_mod(Frame& F) {
    float* red = (float*)F.lds;
    float* MODP = (float*)(F.ws + WS_MODP);
    for (int it = F.vcu; it < 48 * 4; it += F.G) {
        const int cc = it % 48, q = it / 48, n = cc * 64 + F.lane, k0 = q * 256 + F.wave * 32;
        float acc[8];
#pragma unroll
        for (int b = 0; b < 8; ++b) acc[b] = 0.f;
#pragma unroll 8
        for (int kk = 0; kk < 32; ++kk) {
            const float w = F.w_ada[(size_t)(k0 + kk) * 3072 + n];
#pragma unroll
            for (int b = 0; b < 8; ++b) { const float cv = F.c[b * D_ + k0 + kk]; acc[b] += silu_f(cv) * w; }
        }
        __syncthreads();
#pragma unroll
        for (int b = 0; b < 8; ++b) red[(F.wave * 8 + b) * 64 + F.lane] = acc[b];
        __syncthreads();
        {
            float s = 0.f;
#pragma unroll
            for (int w = 0; w < 8; ++w) s += red[(w * 8 + F.wave) * 64 + F.lane];
            MODP[((size_t)q * 8 + F.wave) * 3072 + n] = s;
        }
    }
    __syncthreads();
}
__device__ __forceinline__ void p0_rope(Frame& F) {
    float* ROPE = (float*)(F.ws + WS_ROPE);
    const int gt = F.vcu * 512 + F.tid, NT = F.G * 512;
    for (int e = gt; e < T_ * 8; e += NT) {
        const int t = e >> 3, i = e & 7;
        const double inv = (i == 0) ? 1.0 : (i == 1) ? 0.19392274474868576 : (i == 2) ? 0.03760603093086393 : (i == 3) ? 0.007292664737217109 :
                           (i == 4) ? 0.001414213562373095 : (i == 5) ? 0.0002742481756762073 : (i == 6) ? 5.318295896944988e-05 : 1.031338537721246e-05;
        const double rev = (double)F.pos[t] * inv * 0.15915494309189535;
        const float fr = (float)(rev - floor(rev));
        ROPE[2 * e] = __builtin_amdgcn_cosf(fr); ROPE[2 * e + 1] = __builtin_amdgcn_sinf(fr);
    }
}
__device__ __forceinline__ void p0_weights(Frame& F) {
    float* scr = (float*)(F.lds + 16384 + F.wave * 9216);
    const int gw = F.vcu * 8 + F.wave, NGW = F.G * 8;
    constexpr int I_IN = (D_ / 64) * (DIN / 32), I_PW = (DC / 64) * (DC / 32), I_OUT = (D_ / 64) * (D_ / 32);
    for (int it = gw; it < I_IN + I_PW + I_OUT; it += NGW) {
        int r = it;
        if (r < I_IN) { p0_transpose_item<true>(F.w_in, D_, DIN, (bf16*)(F.ws + WS_WIN), scr, r, F.lane); continue; } r -= I_IN;
        if (r < I_PW) { p0_transpose_item<false>(F.w_pw, DC, DC, (bf16*)(F.ws + WS_WPW), scr, r, F.lane); continue; } r -= I_PW;
        p0_transpose_item<false>(F.w_out, D_, D_, (bf16*)(F.ws + WS_WOUT), scr, r, F.lane);
    }
}
__device__ __forceinline__ float mod_at(Frame& F, int b, int n) {
    const float* MODP = (const float*)(F.ws + WS_MODP);
    float s = F.b_ada[n];
#pragma unroll
    for (int q = 0; q < 4; ++q) s += MODP[((size_t)q * 8 + b) * 3072 + n];
    return s;
}

__device__ __forceinline__ void p1_h(Frame& F) {
    bf16* Hb = (bf16*)(F.ws + WS_H);
    { float* MOD = (float*)(F.ws + WS_MOD); for (int e = F.vcu * 512 + F.tid; e < NB_ * 3072; e += F.G * 512) MOD[e] = mod_at(F, e / 3072, e % 3072); }
    const int gw = F.vcu * 8 + F.wave, NGW = F.G * 8, RPW = 16;
    for (int blk = gw; blk < T_ / RPW; blk += NGW) {
        const int r0 = blk * RPW, b = r0 / S_;
        f32x4 gs[4], sh[4];
#pragma unroll
        for (int j = 0; j < 4; ++j) {
            const int k = 4 * F.lane + 256 * j;
            float g4[4], s4[4];
#pragma unroll
            for (int e = 0; e < 4; ++e) { g4[e] = F.g_norm[k + e] * (1.f + mod_at(F, b, 1024 + k + e)); s4[e] = mod_at(F, b, k + e); }
            gs[j] = (f32x4){g4[0], g4[1], g4[2], g4[3]}; sh[j] = (f32x4){s4[0], s4[1], s4[2], s4[3]};
        }
        for (int r = r0; r < r0 + RPW; ++r) {
            const f32x4* xr = (const f32x4*)(F.x + (size_t)r * D_) + F.lane;
            f32x4 v[4]; float s = 0.f;
#pragma unroll
            for (int j = 0; j < 4; ++j) { v[j] = xr[64 * j]; s += (v[j].x * v[j].x + v[j].y * v[j].y) + (v[j].z * v[j].z + v[j].w * v[j].w); }
            const float rstd = rsqrtf(wave_sum(s) * (1.f / D_) + EPS_);
            unsigned long long* o8 = (unsigned long long*)(Hb + (size_t)r * D_) + F.lane;
#pragma unroll
            for (int j = 0; j < 4; ++j) { const f32x4 h = v[j] * rstd * gs[j] + sh[j];
                o8[64 * j] = (unsigned long long)pk2(h.x, h.y) | ((unsigned long long)pk2(h.z, h.w) << 32); }
        }
    }
}

template <class Epi>
__device__ __forceinline__ void naive_gemm(Frame& F, const bf16* A, int lda, const float* W, int M, int N, int K, const Epi& epi) {
    float* As = (float*)F.lds;
    float* Bs = As + 32 * 132;
    const int tid = F.tid, ty = tid >> 4, tx = tid & 15;
    const int ntn = N / 128, ntiles = (M / 128) * ntn;
    const int arow = tid >> 2, akq = (tid & 3) * 8, bkk = tid >> 4, bn8 = (tid & 15) * 8;
    for (int tile = F.vcu; tile < ntiles; tile += F.G) {
        const int tm = tile / ntn, tn = tile % ntn;
        float acc[4][8];
#pragma unroll
        for (int i = 0; i < 4; ++i)
#pragma unroll
            for (int j = 0; j < 8; ++j) acc[i][j] = 0.f;
        for (int k0 = 0; k0 < K; k0 += 32) {
            const u32x4 av = *(const u32x4*)(A + (size_t)(tm * 128 + arow) * lda + k0 + akq);
            const f32x4 b0 = *(const f32x4*)(W + (size_t)(k0 + bkk) * N + tn * 128 + bn8);
            const f32x4 b1 = *(const f32x4*)(W + (size_t)(k0 + bkk) * N + tn * 128 + bn8 + 4);
            __syncthreads();
            float af[8]; unpack8(av, af);
#pragma unroll
            for (int i = 0; i < 8; ++i) As[(akq + i) * 132 + arow] = af[i];
            *(f32x4*)&Bs[bkk * 132 + bn8] = b0; *(f32x4*)&Bs[bkk * 132 + bn8 + 4] = b1;
            __syncthreads();
#pragma unroll 8
            for (int kk = 0; kk < 32; ++kk) {
                const f32x4 a4 = *(const f32x4*)&As[kk * 132 + ty * 4];
                const f32x4 c0 = *(const f32x4*)&Bs[kk * 132 + tx * 8], c1 = *(const f32x4*)&Bs[kk * 132 + tx * 8 + 4];
                const float a[4] = {a4.x, a4.y, a4.z, a4.w}; const float bb[8] = {c0.x, c0.y, c0.z, c0.w, c1.x, c1.y, c1.z, c1.w};
#pragma unroll
                for (int i = 0; i < 4; ++i)
#pragma unroll
                    for (int j = 0; j < 8; ++j) acc[i][j] += a[i] * bb[j];
            }
        }
#pragma unroll
        for (int i = 0; i < 4; ++i) epi(tm * 128 + ty * 4 + i, tn * 128 + tx * 8, acc[i]);
    }
    __syncthreads();
}
struct EpiStoreBf16 { bf16* O; int ldc;
    __device__ __forceinline__ void operator()(int row, int col, const float (&v)[8]) const { *(u32x4*)(O + (size_t)row * ldc + col) = pack8(v); } };
struct EpiPwNaive { bf16* O; const bf16* SGC; const float* bias;
    __device__ __forceinline__ void operator()(int row, int col, const float (&v)[8]) const {
        float g[8], o[8]; unpack8(*(const u32x4*)(SGC + (size_t)row * DC + col), g);
#pragma unroll
        for (int j = 0; j < 8; ++j) o[j] = (v[j] + bias[col + j]) * g[j];
        *(u32x4*)(O + (size_t)row * D_ + col) = pack8(o); } };
struct EpiOutNaive { float* O; const float* x; const float* modp; const float* b_ada;
    __device__ __forceinline__ void operator()(int row, int col, const float (&v)[8]) const {
        const int b = row / S_;
#pragma unroll
        for (int j = 0; j < 8; ++j) { float g = b_ada[2048 + col + j];
#pragma unroll
            for (int q = 0; q < 4; ++q) g += modp[((size_t)q * 8 + b) * 3072 + 2048 + col + j];
            O[(size_t)row * D_ + col + j] = x[(size_t)row * D_ + col + j] + g * v[j]; } } };

__device__ __forceinline__ void n2_transform(Frame& F) {
    const bf16* P = (const bf16*)(F.ws + WS_P); const float* ROPE = (const float*)(F.ws + WS_ROPE);
    bf16 *U = (bf16*)(F.ws + WS_U), *SGC = (bf16*)(F.ws + WS_SGC), *Q = (bf16*)(F.ws + WS_Q), *K = (bf16*)(F.ws + WS_K), *V = (bf16*)(F.ws + WS_V), *SGA = (bf16*)(F.ws + WS_SGA);
    const int gw = F.vcu * 8 + F.wave, NGW = F.G * 8, c8 = F.lane * 8;
    for (int t = gw; t < T_; t += NGW) {
        const bf16* pr = P + (size_t)t * DIN;
        float a[8], g[8], o[8];
        unpack8(*(const u32x4*)(pr + c8), a); unpack8(*(const u32x4*)(pr + 512 + c8), g);
#pragma unroll
        for (int j = 0; j < 8; ++j) o[j] = a[j] * sigm_f(g[j]);
        *(u32x4*)(U + (size_t)t * DC + c8) = pack8(o);
        unpack8(*(const u32x4*)(pr + 1024 + c8), a);
#pragma unroll
        for (int j = 0; j < 8; ++j) o[j] = silu_f(a[j]);
        *(u32x4*)(SGC + (size_t)t * DC + c8) = pack8(o);
        float cs[8], sn[8];
#pragma unroll
        for (int j = 0; j < 8; ++j) { cs[j] = ROPE[((size_t)t * 8 + j) * 2]; sn[j] = ROPE[((size_t)t * 8 + j) * 2 + 1]; }
#pragma unroll
        for (int which = 0; which < 2; ++which) {
            unpack8(*(const u32x4*)(pr + (which ? 2048 : 1536) + c8), a);
            float p[8];
#pragma unroll
            for (int j = 0; j < 8; ++j) p[j] = __shfl_xor(a[j], 1);
            const int l7 = F.lane & 7;
#pragma unroll
            for (int j = 0; j < 8; ++j) { float r = a[j];
                if (l7 == 0) r = a[j] * cs[j] - p[j] * sn[j];
                else if (l7 == 1) r = a[j] * cs[j] + p[j] * sn[j];
                o[j] = which ? r : r * C2; }
            *(u32x4*)((which ? K : Q) + (size_t)t * DC + c8) = pack8(o);
        }
        *(u32x4*)(V + (size_t)t * DC + c8) = *(const u32x4*)(pr + 2560 + c8);
        unpack8(*(const u32x4*)(pr + 3072 + c8), a);
#pragma unroll
        for (int j = 0; j < 8; ++j) o[j] = silu_f(a[j]);
        *(u32x4*)(SGA + (size_t)t * DC + c8) = pack8(o);
    }
}
__device__ __forceinline__ void n2_kmean(Frame& F) {
    const bf16* K = (const bf16*)(F.ws + WS_K); float* KM = (float*)(F.ws + WS_KMEAN);
    const int gt = F.vcu * 512 + F.tid, NT = F.G * 512;
    for (int e = gt; e < NB_ * NKB * DC; e += NT) {
        const int col = e % DC, blk = (e / DC) % NKB, b = e / (DC * NKB);
        float s = 0.f;
        for (int r = 0; r < KB; ++r) s += bf2f(K[(size_t)(b * S_ + blk * KB + r) * DC + col]);
        KM[(((size_t)b * NH + col / HD) * NKB + blk) * HD + (col % HD)] = s * (1.f / KB);
    }
}

__device__ __forceinline__ void n3_conv(Frame& F) {
    const bf16* U = (const bf16*)(F.ws + WS_U); bf16* ALN = (bf16*)(F.ws + WS_ALN);
    const int gw = F.vcu * 8 + F.wave, NGW = F.G * 8, c8 = F.lane * 8;
    for (int t = gw; t < T_; t += NGW) {
        const int s = t % S_;
        float acc[8];
        { const f32x4 b0 = *(const f32x4*)(F.b_dw + c8), b1 = *(const f32x4*)(F.b_dw + c8 + 4);
          acc[0] = b0.x; acc[1] = b0.y; acc[2] = b0.z; acc[3] = b0.w; acc[4] = b1.x; acc[5] = b1.y; acc[6] = b1.z; acc[7] = b1.w; }
        for (int w = 0; w < CW; ++w) {
            const int sp = s - (CW - 1) + w;
            if (sp < 0) continue;
            float u[8]; unpack8(*(const u32x4*)(U + (size_t)(t - (CW - 1) + w) * DC + c8), u);
            const f32x4 k0 = *(const f32x4*)(F.w_dw + w * DC + c8), k1 = *(const f32x4*)(F.w_dw + w * DC + c8 + 4);
            acc[0] += u[0] * k0.x; acc[1] += u[1] * k0.y; acc[2] += u[2] * k0.z; acc[3] += u[3] * k0.w;
            acc[4] += u[4] * k1.x; acc[5] += u[5] * k1.y; acc[6] += u[6] * k1.z; acc[7] += u[7] * k1.w;
        }
        float sm = 0.f;
#pragma unroll
        for (int j = 0; j < 8; ++j) sm += acc[j];
        const float mu = wave_sum(sm) * (1.f / DC);
        float sq = 0.f;
#pragma unroll
        for (int j = 0; j < 8; ++j) { acc[j] -= mu; sq += acc[j] * acc[j]; }
        const float rstd = rsqrtf(wave_sum(sq) * (1.f / DC) + EPS_);
        float o[8];
#pragma unroll
        for (int j = 0; j < 8; ++j) o[j] = silu_f(acc[j] * rstd * F.g_ln[c8 + j] + F.b_ln[c8 + j]);
        *(u32x4*)(ALN + (size_t)t * DC + c8) = pack8(o);
    }
}

__device__ __forceinline__ void n3_attn(Frame& F) {
    const bf16 *Q = (const bf16*)(F.ws + WS_Q), *K = (const bf16*)(F.ws + WS_K), *V = (const bf16*)(F.ws + WS_V), *SGA = (const bf16*)(F.ws + WS_SGA);
    const float* KM = (const float*)(F.ws + WS_KMEAN); bf16* Y = (bf16*)(F.ws + WS_YCAT);
    float* qs = (float*)F.lds + F.wave * 64;
    float* ps = (float*)F.lds + 512 + F.wave * 1024;
    const int gw = F.vcu * 8 + F.wave, NGW = F.G * 8, lane = F.lane;
    for (int it = gw; it < T_ * NH; it += NGW) {
        const int h = it % NH, t = it / NH, b = t / S_, s = t % S_, qb = s / KB;
        const float qv = bf2f(Q[(size_t)t * DC + h * HD + lane]);
        qs[lane] = qv;
        __builtin_amdgcn_s_waitcnt(0); __builtin_amdgcn_wave_barrier();
        float gate = -3.0e38f;
        if (lane < qb) { const float* km = KM + (((size_t)b * NH + h) * NKB + lane) * HD; float g = 0.f;
            for (int d = 0; d < HD; ++d) g += qs[d] * km[d];
            gate = g; }
        int sel0 = -1, sel1 = -1, sel2 = -1;
        {
            float g0 = -3.0e38f, g1 = -3.0e38f, g2 = -3.0e38f;
            for (int j = 0; j < NKB; ++j) { const float gj = __shfl(gate, j);
                if (j < qb) {
                    if (gj > g0) { g2 = g1; sel2 = sel1; g1 = g0; sel1 = sel0; g0 = gj; sel0 = j; }
                    else if (gj > g1) { g2 = g1; sel2 = sel1; g1 = gj; sel1 = j; }
                    else if (gj > g2) { g2 = gj; sel2 = j; } } }
        }
        float lg[4][4]; float mx = -3.0e38f;
#pragma unroll
        for (int sl = 0; sl < 4; ++sl) {
            const int blk = (sl == 0) ? qb : (sl == 1) ? sel0 : (sl == 2) ? sel1 : sel2;
#pragma unroll
            for (int kk = 0; kk < 4; ++kk) {
                const int key = lane + 64 * kk; float l = -3.0e38f;
                if (blk >= 0 && (sl > 0 || blk * KB + key <= s)) {
                    const bf16* kr = K + (size_t)(b * S_ + blk * KB + key) * DC + h * HD; float a = 0.f;
#pragma unroll
                    for (int d8 = 0; d8 < 8; ++d8) { float kf[8]; unpack8(*(const u32x4*)(kr + d8 * 8), kf);
#pragma unroll
                        for (int e = 0; e < 8; ++e) a += qs[d8 * 8 + e] * kf[e]; }
                    l = a; }
                lg[sl][kk] = l; mx = fmaxf(mx, l);
            }
        }
        mx = wave_max(mx);
        float sum = 0.f;
#pragma unroll
        for (int sl = 0; sl < 4; ++sl)
#pragma unroll
            for (int kk = 0; kk < 4; ++kk) { const float p = (lg[sl][kk] > -1.0e38f) ? exp2f(lg[sl][kk] - mx) : 0.f; sum += p; ps[sl * 256 + lane + 64 * kk] = bf2f(f2bf(p)); }
        sum = wave_sum(sum);
        __builtin_amdgcn_s_waitcnt(0); __builtin_amdgcn_wave_barrier();
        float o = 0.f;
#pragma unroll
        for (int sl = 0; sl < 4; ++sl) {
            const int blk = (sl == 0) ? qb : (sl == 1) ? sel0 : (sl == 2) ? sel1 : sel2;
            if (blk < 0) continue;
            const int nk = (sl == 0) ? (s - qb * KB + 1) : KB;
            const bf16* vr = V + (size_t)(b * S_ + blk * KB) * DC + h * HD + lane;
            for (int key = 0; key < nk; ++key) o += ps[sl * 256 + key] * bf2f(vr[(size_t)key * DC]);
        }
        const float y = o / sum * bf2f(SGA[(size_t)t * DC + h * HD + lane]);
        Y[(size_t)t * D_ + DC + h * HD + lane] = (bf16)f2bf(y);
        __builtin_amdgcn_s_waitcnt(0); __builtin_amdgcn_wave_barrier();
    }
}

__device__ __forceinline__ void p6_final(Frame& F) {
    const int gw = F.vcu * 8 + F.wave, NGW = F.G * 8;
    f32x4 g[4];
#pragma unroll
    for (int j = 0; j < 4; ++j) g[j] = *((const f32x4*)F.g_final + F.lane + 64 * j);
    for (int r = gw; r < T_; r += NGW) {
        f32x4* xr = (f32x4*)(F.out + (size_t)r * D_) + F.lane;
        f32x4 v[4]; float s = 0.f;
#pragma unroll
        for (int j = 0; j < 4; ++j) { v[j] = xr[64 * j]; s += (v[j].x * v[j].x + v[j].y * v[j].y) + (v[j].z * v[j].z + v[j].w * v[j].w); }
        const float rstd = rsqrtf(wave_sum(s) * (1.f / D_) + EPS_);
#pragma unroll
        for (int j = 0; j < 4; ++j) xr[64 * j] = v[j] * rstd * g[j];
    }
}

#include <hip/hip_bf16.h>
#include <cmath>
namespace attn_body {
using bf16=__hip_bfloat16;
using bf16x8=__attribute__((ext_vector_type(8)))short;
using s16x4=__attribute__((ext_vector_type(4)))short;
using f32x16=__attribute__((ext_vector_type(16)))float;
using u32x4=__attribute__((ext_vector_type(4)))unsigned;
constexpr int BATCH=8,NHEAD=8,SEQ=4096,D=64,DM=NHEAD*D,YP=1024,YOFF=512;
constexpr int NW=8,QBLK=32,QB=QBLK*NW,KVBLK=64,NQB=SEQ/QB;
constexpr int ATTN_PITCH=DM, ATTN_UNIT_ROWS=QB;
__device__ __forceinline__ int crow(int r,int hi){return (r&3)+8*(r>>2)+4*hi;}
#define SBAR() __builtin_amdgcn_sched_barrier(0)
__device__ __forceinline__ void cmask(f32x16&p0,f32x16&p1,int jb,int qrel,int hi){
  const float NEG=-INFINITY; int kb=64*jb+4*hi;
  #pragma unroll
  for(int r=0;r<16;++r){int kv=kb+(r&3)+8*(r>>2); if(kv>qrel)p0[r]=NEG; if(kv+32>qrel)p1[r]=NEG;}
}

constexpr int NSLOT=3, SLOTB=8192;
constexpr int LDS_K=0, LDS_V=NSLOT*SLOTB, LDS_WS=2*NSLOT*SLOTB, LDS_OST=LDS_WS+NW*64*4, LDS_BYTES=LDS_OST+NW*4096;
constexpr float C2=0.125f*1.4426950408889634f;
__device__ __forceinline__ void glds16(const void*gsrc,unsigned lds_dst){unsigned keep;
  asm volatile("s_mov_b32 %0, m0\n\ts_mov_b32 m0, %2\n\ts_nop 0\n\tglobal_load_lds_dwordx4 %1, off\n\ts_mov_b32 m0, %0":"=&s"(keep):"v"(gsrc),"s"(lds_dst):"memory");}
__device__ __forceinline__ float max3f(float a,float b,float c){float r;asm("v_max3_f32 %0, %1, %2, %3":"=v"(r):"v"(a),"v"(b),"v"(c));return r;}
__device__ __forceinline__ float max2f(float a,float b){float r;asm("v_max_f32_e32 %0, %1, %2":"=v"(r):"v"(a),"v"(b));return r;}
__device__ __forceinline__ float fadd_s(float a,float b){float r;asm("v_add_f32_e32 %0, %1, %2":"=v"(r):"v"(a),"v"(b));return r;}
__device__ __forceinline__ float fsub_s(float a,float b){float r;asm("v_sub_f32_e32 %0, %1, %2":"=v"(r):"v"(a),"v"(b));return r;}
typedef float f32x2_t __attribute__((ext_vector_type(2))); typedef __bf16 bf16x2_t __attribute__((ext_vector_type(2)));
__device__ __forceinline__ unsigned cvtpk_s(float lo,float hi){f32x2_t v={lo,hi};bf16x2_t b=__builtin_convertvector(v,bf16x2_t);return __builtin_bit_cast(unsigned,b);}
#define WAIT_BAR(N) asm volatile("s_waitcnt vmcnt(" #N ") lgkmcnt(0)\n\ts_barrier":::"memory")

__device__ __forceinline__ void qkt(f32x16&p0,f32x16&p1,const char*Kslot,const bf16x8*qr,const f32x16&negm,int r32,int hi){
  const char*kb=Kslot+hi*1024+r32*16;
  #pragma unroll
  for(int d0=0;d0<4;++d0){
    const bf16x8 b0=*reinterpret_cast<const bf16x8*>(kb+d0*2048);
    const bf16x8 b1=*reinterpret_cast<const bf16x8*>(kb+d0*2048+512);
    if(d0==0){p0=__builtin_amdgcn_mfma_f32_32x32x16_bf16(b0,qr[0],negm,0,0,0);p1=__builtin_amdgcn_mfma_f32_32x32x16_bf16(b1,qr[0],negm,0,0,0);}
    else{p0=__builtin_amdgcn_mfma_f32_32x32x16_bf16(b0,qr[d0],p0,0,0,0);p1=__builtin_amdgcn_mfma_f32_32x32x16_bf16(b1,qr[d0],p1,0,0,0);}}
}
typedef __attribute__((address_space(3))) const char* lds_cptr;
typedef short v4i16_t __attribute__((ext_vector_type(4)));
__device__ __forceinline__ void kload8(bf16x8*kf,lds_cptr kp){
  kf[0]=*(const __attribute__((address_space(3))) bf16x8*)(kp);      kf[1]=*(const __attribute__((address_space(3))) bf16x8*)(kp+512);
  kf[2]=*(const __attribute__((address_space(3))) bf16x8*)(kp+2048); kf[3]=*(const __attribute__((address_space(3))) bf16x8*)(kp+2560);
  kf[4]=*(const __attribute__((address_space(3))) bf16x8*)(kp+4096); kf[5]=*(const __attribute__((address_space(3))) bf16x8*)(kp+4608);
  kf[6]=*(const __attribute__((address_space(3))) bf16x8*)(kp+6144); kf[7]=*(const __attribute__((address_space(3))) bf16x8*)(kp+6656);
}
__device__ __forceinline__ void kload2(bf16x8*kf,lds_cptr kp,int j){ kf[2*j]=*(const __attribute__((address_space(3))) bf16x8*)(kp+j*2048); kf[2*j+1]=*(const __attribute__((address_space(3))) bf16x8*)(kp+j*2048+512); }
__device__ __forceinline__ s16x4 vtr(lds_cptr p){ return __builtin_bit_cast(s16x4,__builtin_amdgcn_ds_read_tr16_b64_v4i16((__attribute__((address_space(3))) v4i16_t*)p)); }
__device__ __forceinline__ float rowmax(const f32x16&p0,const f32x16&p1){
  float a=max3f(p0[0],p0[1],p1[0]),b=max3f(p0[2],p0[3],p1[1]);a=max3f(a,p1[2],p1[3]);
  #pragma unroll
  for(int r=4;r<16;r+=4){a=max3f(a,p0[r],p0[r+1]);b=max3f(b,p0[r+2],p0[r+3]);a=max3f(a,p1[r],p1[r+1]);b=max3f(b,p1[r+2],p1[r+3]);}
  const float m=max2f(a,b);
  auto rr=__builtin_amdgcn_permlane32_swap(__float_as_uint(m),__float_as_uint(m),false,false);
  return max2f(__uint_as_float(rr[0]),__uint_as_float(rr[1]));
}
__device__ __forceinline__ void pv(f32x16*o,int vb,bf16x8 pa0,bf16x8 pa1,bf16x8 pa2,bf16x8 pa3){
  #pragma unroll
  for(int d0=0;d0<2;++d0){s16x4 lo[4],hi[4];
    #pragma unroll
    for(int ks=0;ks<4;++ks){
      asm volatile("ds_read_b64_tr_b16 %0,%1 offset:%c2":"=&v"(lo[ks]):"v"(vb),"i"(d0*4096+ks*1024):"memory");
      asm volatile("ds_read_b64_tr_b16 %0,%1 offset:%c2":"=&v"(hi[ks]):"v"(vb),"i"(d0*4096+ks*1024+512):"memory");}
    asm volatile("s_waitcnt lgkmcnt(0)":::"memory");SBAR();
    #define PK(k) (bf16x8){lo[k][0],lo[k][1],lo[k][2],lo[k][3],hi[k][0],hi[k][1],hi[k][2],hi[k][3]}
    o[d0]=__builtin_amdgcn_mfma_f32_32x32x16_bf16(pa0,PK(0),o[d0],0,0,0);
    o[d0]=__builtin_amdgcn_mfma_f32_32x32x16_bf16(pa1,PK(1),o[d0],0,0,0);
    o[d0]=__builtin_amdgcn_mfma_f32_32x32x16_bf16(pa2,PK(2),o[d0],0,0,0);
    o[d0]=__builtin_amdgcn_mfma_f32_32x32x16_bf16(pa3,PK(3),o[d0],0,0,0);
    #undef PK
  }
}

#ifndef ATTN_STORE16
#define ATTN_STORE16(p,v) (*(u32x4*)(p)=(v))
#endif
template<int THRL> __device__ __forceinline__ void attn_unit(int b,int h,int qb,const bf16*Q,const bf16*__restrict__ K,const bf16*__restrict__ V,bf16*O,const bf16*__restrict__ SG,const float*__restrict__ KM,char*shm,int wave_s){
  const int lane=mk_lane(),r32=lane&31,hi=lane>>5; const int wid=__builtin_amdgcn_readfirstlane(wave_s);
  const long rowbase=(long)b*SEQ; const int q0=qb*QB;
  const bf16*Qw=Q+(rowbase+q0+wid*QBLK)*DM+h*D;
  const bf16*Kh=K+rowbase*DM+h*D,*Vh=V+rowbase*DM+h*D;
  const unsigned lds0=(unsigned)(uintptr_t)shm;
  float*wsf=(float*)(shm+LDS_WS)+wid*64;
  const bf16*ksrc=Kh+(long)lane*DM+wid*8;
  const bf16*vsrc=Vh+(long)(16*(wid&3)+(lane>>2))*DM+(wid>>2)*32+(lane&3)*8;
  const unsigned kdst=lds0+LDS_K+wid*1024, vdst=lds0+LDS_V+wid*1024;
  #define DMA_K(t,slot) glds16(ksrc+(long)(t)*KVBLK*DM,(unsigned)__builtin_amdgcn_readfirstlane(kdst+(slot)))
  #define DMA_V(t,slot) glds16(vsrc+(long)(t)*KVBLK*DM,(unsigned)__builtin_amdgcn_readfirstlane(vdst+(slot)))
  const int vb0=(int)(lds0+LDS_V)+((lane>>4)&1)*32+(lane&3)*8+(4*hi+((lane&15)>>2))*64;
  const char*Kbase=shm+LDS_K; bf16x8 kf[8];
  const lds_cptr shm3=(lds_cptr)shm; const lds_cptr kp0=shm3+LDS_K+hi*1024+r32*16; const lds_cptr vp0=shm3+LDS_V+((lane>>4)&1)*32+(lane&3)*8+(4*hi+((lane&15)>>2))*64;
  const int NT=(q0+QB)/KVBLK;
  DMA_K(0,0);DMA_V(0,0);DMA_K(1,SLOTB);
  unsigned selbits=0u;
  if(qb>0){
    float qf[32];
    #pragma unroll
    for(int c=0;c<4;++c){ const u32x4 w=*reinterpret_cast<const u32x4*>(&Qw[(long)r32*DM+hi*32+c*8]);
      qf[c*8+0]=__uint_as_float(w.x<<16);qf[c*8+1]=__uint_as_float(w.x&0xffff0000u);qf[c*8+2]=__uint_as_float(w.y<<16);qf[c*8+3]=__uint_as_float(w.y&0xffff0000u);
      qf[c*8+4]=__uint_as_float(w.z<<16);qf[c*8+5]=__uint_as_float(w.z&0xffff0000u);qf[c*8+6]=__uint_as_float(w.w<<16);qf[c*8+7]=__uint_as_float(w.w&0xffff0000u); }
    const float*kmb=KM+((long)(b*NHEAD+h)*NQB)*D+hi*32;
    float g0=-3.0e38f,g1=-3.0e38f,g2=-3.0e38f; int s0=-1,s1=-1,s2=-1;
    for(int j=0;j<qb;++j){ const float*km=kmb+j*D; float a=0.f;
      #pragma unroll
      for(int c=0;c<8;++c){ const float4 kv=*reinterpret_cast<const float4*>(km+c*4); a+=qf[c*4]*kv.x; a+=qf[c*4+1]*kv.y; a+=qf[c*4+2]*kv.z; a+=qf[c*4+3]*kv.w; }
      const float gj=a+__shfl_xor(a,32);
      if(gj>g0){g2=g1;s2=s1;g1=g0;s1=s0;g0=gj;s0=j;} else if(gj>g1){g2=g1;s2=s1;g1=gj;s1=j;} else if(gj>g2){g2=gj;s2=j;} }
    if(s0>=0)selbits|=1u<<s0; if(s1>=0)selbits|=1u<<s1; if(s2>=0)selbits|=1u<<s2;
  }
  bf16x8 qr[4];
  #pragma unroll
  for(int d0=0;d0<4;++d0)qr[d0]=*reinterpret_cast<const bf16x8*>(&Qw[(long)r32*DM+d0*16+hi*8]);
  float mhat=0.f,l_reg=0.f;f32x16 o[2];o[0]=f32x16{};o[1]=f32x16{};f32x16 negm=f32x16{};asm volatile("":"+v"(negm));
  const int qrel=wid*QBLK+r32;
  #define SELM(P0,P1,t) do{ if(!((selbits>>((t)>>2))&1u)){ _Pragma("unroll") for(int r=0;r<16;++r){P0[r]=-INFINITY;P1[r]=-INFINITY;} } }while(0)
  #define CMASK(P0,P1,t) do{int jb_=(t)-(NT-4); if(jb_>=0)cmask(P0,P1,jb_,qrel,hi); else SELM(P0,P1,t);}while(0)
  bool resc=false;
  #define START(P0,P1) do{ const float rm=rowmax(P0,P1); resc=false; \
    { const float dl=__builtin_fmaxf(rm,-60.f); mhat=fadd_s(mhat,dl); \
      _Pragma("unroll") for(int r=0;r<16;++r){P0[r]=fsub_s(P0[r],dl);P1[r]=fsub_s(P1[r],dl);} \
      _Pragma("unroll") for(int r=0;r<16;++r)negm[r]=-mhat; asm volatile("":"+v"(negm)); } \
    _Pragma("unroll") for(int r=0;r<16;++r)P0[r]=__builtin_amdgcn_exp2f(P0[r]); }while(0)
  #define RESC() do{ if(resc){ asm volatile("s_waitcnt lgkmcnt(0)":::"memory"); \
      _Pragma("unroll") for(int d_=0;d_<2;++d_) _Pragma("unroll") for(int r=0;r<16;++r)o[d_][r]*=wsf[crow(r,hi)]; } }while(0)
  f32x16 pA0,pA1,pB0,pB1;
  int sl_prev=0,sl_cur=0,sl_next=SLOTB;
  #define ROT() do{sl_prev=sl_cur;sl_cur=sl_next;sl_next=(sl_next==(NSLOT-1)*SLOTB)?0:sl_next+SLOTB;}while(0)
  DMA_K(2,2*SLOTB);
  WAIT_BAR(3);
  qkt(pA0,pA1,Kbase,qr,negm,r32,hi);asm volatile("s_nop 15\n\ts_nop 7":"+v"(pA0),"+v"(pA1));CMASK(pA0,pA1,0);
  START(pA0,pA1);
  _Pragma("unroll") for(int r=0;r<16;++r)pA1[r]=__builtin_amdgcn_exp2f(pA1[r]);
  WAIT_BAR(0);
  DMA_K(3,0);DMA_V(1,SLOTB);
  ROT();
  kload8(kf,kp0+sl_cur);
  WAIT_BAR(2);
  s16x4 vlo[8],vhi[8]; u32x4 pw0,pw1,pw2,pw3;
  #define PKW(P,B) cvtpk_s(P[B],P[B+1])
  #define PAF(k) __builtin_bit_cast(bf16x8,pw##k)
  #define VFR(i) (bf16x8){vlo[i][0],vlo[i][1],vlo[i][2],vlo[i][3],vhi[i][0],vhi[i][1],vhi[i][2],vhi[i][3]}
  #define PIN(x) asm volatile("":"+v"(x))
  #define MX3(a,b,c) __builtin_fmaxf(__builtin_fmaxf((a),(b)),(c))
  #define GAPA(MF,A0,A1,A2,A3,W0,W1,PW) do{ MF; sacc+=A0; sacc+=A1; sacc+=A2; sacc+=A3; PIN(sacc); W0; W1; PIN(PW); SBAR(); }while(0)
  #define EX(v) __builtin_amdgcn_exp2f(v)
  #define GAPB(MF,X,B) do{ MF; X[B]=EX(X[B]); X[B+1]=EX(X[B+1]); X[B+2]=EX(X[B+2]); X[B+3]=EX(X[B+3]); PIN(X); SBAR(); }while(0)
  #define VRD(i) do{ vlo[i]=vtr(vp_+(((i)>>2)*4096+((i)&3)*1024)); vhi[i]=vtr(vp_+(((i)>>2)*4096+((i)&3)*1024+512)); }while(0)
  #define KRD(G,j) do{ if(G){ kload2(kf,kp0+sl_next,j); SBAR(); } }while(0)
  #define STEP(C0,C1,P0,P1,t,GK,GV,GL) do{ SBAR(); \
    const lds_cptr vp_=vp0+sl_prev; \
    VRD(0); SBAR(); float sacc=(P0[0]+P0[1]); \
    GAPA(C0=__builtin_amdgcn_mfma_f32_32x32x16_bf16(kf[0],qr[0],negm,0,0,0), P0[2],P0[3],P0[4],P0[5],     pw0[0]=PKW(P0,0), pw0[1]=PKW(P0,2), pw0); \
    VRD(4); SBAR(); GAPA(C1=__builtin_amdgcn_mfma_f32_32x32x16_bf16(kf[1],qr[0],negm,0,0,0), P0[6],P0[7],P0[8],P0[9],     pw0[2]=PKW(P0,4), pw0[3]=PKW(P0,6), pw0); \
    VRD(1); SBAR(); GAPA(C0=__builtin_amdgcn_mfma_f32_32x32x16_bf16(kf[2],qr[1],C0,0,0,0),   P0[10],P0[11],P0[12],P0[13], pw1[0]=PKW(P0,8), pw1[1]=PKW(P0,10), pw1); \
    VRD(5); SBAR(); GAPA(C1=__builtin_amdgcn_mfma_f32_32x32x16_bf16(kf[3],qr[1],C1,0,0,0),   P0[14],P0[15],P1[0],P1[1],   pw1[2]=PKW(P0,12),pw1[3]=PKW(P0,14), pw1); \
    VRD(2); SBAR(); GAPA(C0=__builtin_amdgcn_mfma_f32_32x32x16_bf16(kf[4],qr[2],C0,0,0,0),   P1[2],P1[3],P1[4],P1[5],     pw2[0]=PKW(P1,0), pw2[1]=PKW(P1,2), pw2); \
    VRD(6); SBAR(); GAPA(C1=__builtin_amdgcn_mfma_f32_32x32x16_bf16(kf[5],qr[2],C1,0,0,0),   P1[6],P1[7],P1[8],P1[9],     pw2[2]=PKW(P1,4), pw2[3]=PKW(P1,6), pw2); \
    VRD(3); SBAR(); GAPA(C0=__builtin_amdgcn_mfma_f32_32x32x16_bf16(kf[6],qr[3],C0,0,0,0),   P1[10],P1[11],P1[12],P1[13], pw3[0]=PKW(P1,8), pw3[1]=PKW(P1,10), pw3); \
    VRD(7); SBAR(); GAPA(C1=__builtin_amdgcn_mfma_f32_32x32x16_bf16(kf[7],qr[3],C1,0,0,0),   P1[14],P1[15],0.f,0.f,       pw3[2]=PKW(P1,12),pw3[3]=PKW(P1,14), pw3); \
    l_reg+=sacc; \
    if(GK){DMA_K((t)+3,sl_cur);} if(GV){DMA_V((t)+1,sl_next);} \
    CMASK(C0,C1,t); \
    { float a=MX3(C0[0],C0[1],C1[0]),b=MX3(C0[2],C0[3],C1[1]); a=MX3(a,C1[2],C1[3]); \
      _Pragma("unroll") for(int r=4;r<16;r+=4){a=MX3(a,C0[r],C0[r+1]);b=MX3(b,C0[r+2],C0[r+3]);a=MX3(a,C1[r],C1[r+1]);b=MX3(b,C1[r+2],C1[r+3]);} \
      float rm=__builtin_fmaxf(a,b); { auto rr=__builtin_amdgcn_permlane32_swap(__float_as_uint(rm),__float_as_uint(rm),false,false); rm=__builtin_fmaxf(__uint_as_float(rr[0]),__uint_as_float(rr[1])); } \
      resc=false; \
      if(__builtin_expect(__any(rm>(float)THRL),0)){ const float dl=__builtin_fmaxf(rm,0.f); mhat+=dl; \
        _Pragma("unroll") for(int r=0;r<16;++r){C0[r]-=dl;C1[r]-=dl;} \
        _Pragma("unroll") for(int r=0;r<16;++r)negm[r]=-mhat; asm volatile("":"+v"(negm)); \
        const float f=__builtin_amdgcn_exp2f(-dl); l_reg*=f; if(hi==0)wsf[r32]=f; resc=true; } } \
    SBAR(); \
    GAPB(o[0]=__builtin_amdgcn_mfma_f32_32x32x16_bf16(PAF(0),VFR(0),o[0],0,0,0), C0,0); \
    GAPB(o[1]=__builtin_amdgcn_mfma_f32_32x32x16_bf16(PAF(0),VFR(4),o[1],0,0,0), C0,4); \
    KRD(GL,0); GAPB(o[0]=__builtin_amdgcn_mfma_f32_32x32x16_bf16(PAF(1),VFR(1),o[0],0,0,0), C0,8); \
    KRD(GL,1); GAPB(o[1]=__builtin_amdgcn_mfma_f32_32x32x16_bf16(PAF(1),VFR(5),o[1],0,0,0), C0,12); \
    KRD(GL,2); GAPB(o[0]=__builtin_amdgcn_mfma_f32_32x32x16_bf16(PAF(2),VFR(2),o[0],0,0,0), C1,0); \
    KRD(GL,3); GAPB(o[1]=__builtin_amdgcn_mfma_f32_32x32x16_bf16(PAF(2),VFR(6),o[1],0,0,0), C1,4); \
    GAPB(o[0]=__builtin_amdgcn_mfma_f32_32x32x16_bf16(PAF(3),VFR(3),o[0],0,0,0), C1,8); \
    GAPB(o[1]=__builtin_amdgcn_mfma_f32_32x32x16_bf16(PAF(3),VFR(7),o[1],0,0,0), C1,12); \
    }while(0)
  int t=1;
  #undef CMASK
  #define CMASK(P0,P1,t) SELM(P0,P1,t)
  for(;t+5<NT;t+=2){
    STEP(pB0,pB1,pA0,pA1,t,true,true,true);     WAIT_BAR(2); RESC(); ROT();
    STEP(pA0,pA1,pB0,pB1,t+1,true,true,true);   WAIT_BAR(2); RESC(); ROT();
  }
  #undef CMASK
  #define CMASK(P0,P1,t) do{int jb_=(t)-(NT-4); if(jb_>=0)cmask(P0,P1,jb_,qrel,hi); else SELM(P0,P1,t);}while(0)
  #define ENDW(tt) do{ if((tt)+3<NT){WAIT_BAR(2);} else if((tt)+2<NT){WAIT_BAR(1);} else {WAIT_BAR(0);} }while(0)
  for(;t+1<NT;t+=2){
    STEP(pB0,pB1,pA0,pA1,t,(t+3<NT),(t+1<NT),(t+1<NT));       ENDW(t);   RESC(); ROT();
    STEP(pA0,pA1,pB0,pB1,t+1,(t+4<NT),(t+2<NT),(t+2<NT));     ENDW(t+1); RESC(); ROT();
  }
  STEP(pB0,pB1,pA0,pA1,NT-1,false,false,false); RESC();
  { float sacc=pB0[0]+pB0[1]; _Pragma("unroll") for(int r=2;r<16;++r)sacc+=pB0[r]; _Pragma("unroll") for(int r=0;r<16;++r)sacc+=pB1[r]; l_reg+=sacc;
    pw0=(u32x4){PKW(pB0,0),PKW(pB0,2),PKW(pB0,4),PKW(pB0,6)};pw1=(u32x4){PKW(pB0,8),PKW(pB0,10),PKW(pB0,12),PKW(pB0,14)};pw2=(u32x4){PKW(pB1,0),PKW(pB1,2),PKW(pB1,4),PKW(pB1,6)};pw3=(u32x4){PKW(pB1,8),PKW(pB1,10),PKW(pB1,12),PKW(pB1,14)};
    SBAR(); pv(o,vb0+sl_cur,PAF(0),PAF(1),PAF(2),PAF(3)); }
  #undef PKW
  #undef PAF
  #undef VFR
  #undef PIN
  #undef MX3
  #undef GAPA
  #undef GAPB
  #undef EX
  #undef VRD
  #undef KRD
  #undef STEP
  #undef ENDW
  {auto rr=__builtin_amdgcn_permlane32_swap(__float_as_uint(l_reg),__float_as_uint(l_reg),false,false);l_reg=__uint_as_float(rr[0])+__uint_as_float(rr[1]);}
  if(hi==0)wsf[32+r32]=l_reg;asm volatile("s_waitcnt lgkmcnt(0)":::"memory");
  float rli[16];
  #pragma unroll
  for(int r=0;r<16;++r)rli[r]=__builtin_amdgcn_rcpf(wsf[32+crow(r,hi)]);
  bf16*Ow=O+(rowbase+q0+wid*QBLK)*YP+YOFF+h*D; const bf16*Gw=SG+(rowbase+q0+wid*QBLK)*DM+h*D;
  { bf16*stg=(bf16*)(shm+LDS_OST)+wid*2048;
    #pragma unroll
    for(int r=0;r<16;++r){const int orow=crow(r,hi);
      #pragma unroll
      for(int d0=0;d0<2;++d0)stg[orow*64+d0*32+r32]=__float2bfloat16(o[d0][r]*rli[r]);}
    asm volatile("s_waitcnt lgkmcnt(0)":::"memory");
    int le=lane; asm volatile("":"+v"(le));
    #pragma unroll
    for(int i=0;i<4;++i){const int row=i*8+(le>>3),ch=le&7; const u32x4 v=*(const u32x4*)(stg+row*64+ch*8); const u32x4 g=*(const u32x4*)(Gw+(row*DM+ch*8)); u32x4 w;
      w.x=cvtpk_s(__uint_as_float(v.x<<16)*__uint_as_float(g.x<<16),__uint_as_float(v.x&0xffff0000u)*__uint_as_float(g.x&0xffff0000u));
      w.y=cvtpk_s(__uint_as_float(v.y<<16)*__uint_as_float(g.y<<16),__uint_as_float(v.y&0xffff0000u)*__uint_as_float(g.y&0xffff0000u));
      w.z=cvtpk_s(__uint_as_float(v.z<<16)*__uint_as_float(g.z<<16),__uint_as_float(v.z&0xffff0000u)*__uint_as_float(g.z&0xffff0000u));
      w.w=cvtpk_s(__uint_as_float(v.w<<16)*__uint_as_float(g.w<<16),__uint_as_float(v.w&0xffff0000u)*__uint_as_float(g.w&0xffff0000u));
      ATTN_STORE16(Ow+(row*YP+ch*8),w);} }
  asm volatile("s_waitcnt lgkmcnt(0)\n\ts_barrier":::"memory");
  #undef DMA_K
  #undef DMA_V
  #undef CMASK
  #undef SELM
  #undef START
  #undef RESC
  #undef ROT
}
constexpr int ATTN_LDS_BYTES=LDS_BYTES;
struct AttnTensors { const bf16* Q; const bf16* K; const bf16* V; bf16* O; const bf16* SG; const float* KM; };
struct AttnUnit { int bh; int qb; };
struct StaticOrder {
  int vcu;
  __device__ __forceinline__ explicit StaticOrder(int grid,int block):vcu((block%8)*(grid/8)+block/8){}
  __device__ __forceinline__ bool next(int i,AttnUnit&u)const{ if(i>=4)return false; const int s=vcu&3; u.bh=vcu>>2; u.qb=(i==0)?15-s:(i==1)?8+s:(i==2)?7-s:s; return true; }
  __device__ __forceinline__ void a_ready(const AttnUnit&)const{}
  __device__ __forceinline__ void done(const AttnUnit&)const{}
};
template<class Sched,int THRL=8> __device__ __forceinline__ void attn_phase(char*lds,const AttnTensors&T,const Sched&S,int wave_s){
  AttnUnit u;
  for(int i=0;S.next(i,u);++i){ S.a_ready(u); attn_unit<THRL>(u.bh/NHEAD,u.bh%NHEAD,u.qb,T.Q,T.K,T.V,T.O,T.SG,T.KM,lds,wave_s); S.done(u); }
}
#undef SBAR
#undef WAIT_BAR
}

#define LAS __attribute__((address_space(3)))
#define XB_TMO      128
#define XB_XCNT(j)  (256  + 64 * (j))
#define XB_XSUB(j)  (1280 + 64 * (j))
#define XB_XGEN(j)  (2304 + 64 * (j))
#define XB_TOP      3328
#define XB_TOPGEN   3392
#define XCD_BAR_WORDS 3456
#define XB_SPIN_CAP (1u << 18)

__device__ __forceinline__ unsigned xb_ld(unsigned* p)              { return __hip_atomic_load(p, __ATOMIC_RELAXED, __HIP_MEMORY_SCOPE_AGENT); }
__device__ __forceinline__ unsigned xb_add(unsigned* p, unsigned v) { return __hip_atomic_fetch_add(p, v, __ATOMIC_RELAXED, __HIP_MEMORY_SCOPE_AGENT); }
__device__ __forceinline__ unsigned xb_xcc_id() { return (unsigned)__builtin_amdgcn_s_getreg((3 << 11) | 20) & 0xFu; }
#define XB_SPIN(cond, bar) do { unsigned _sp = 0; while (cond) { __builtin_amdgcn_s_sleep(1); \
    if ((++_sp & 255u) == 0u) { if (xb_ld(&(bar)[XB_TMO])) break; if (_sp > XB_SPIN_CAP) { atomicAdd(&(bar)[XB_TMO], 1u); break; } } } } while (0)

struct XcdBarrier {
    unsigned* bar; unsigned x;
    volatile LAS unsigned* st;
};

__device__ __forceinline__ XcdBarrier xcd_barrier_post(unsigned* bar, volatile LAS unsigned* st) {
    XcdBarrier b; b.bar = bar; b.x = xb_xcc_id(); b.st = st;
    if (threadIdx.x == 0) (void)xb_add(&bar[XB_XCNT(b.x)], 1u);
    return b;
}
__device__ __forceinline__ void xcd_barrier_complete(unsigned* bar, unsigned x, unsigned& nloc, unsigned& nx) {
    const unsigned G = gridDim.x * gridDim.y * gridDim.z;
    unsigned sum, cnt, mine, sp = 0u;
    for (;;) {
        sum = 0u; cnt = 0u; mine = 0u;
#pragma unroll
        for (unsigned j = 0; j < 16; ++j) { const unsigned c = xb_ld(&bar[XB_XCNT(j)]); sum += c; cnt += (c > 0u) ? 1u : 0u; mine = (j == x) ? c : mine; }
        if (sum == G) break;
        __builtin_amdgcn_s_sleep(1);
        if ((++sp & 255u) == 0u) { if (xb_ld(&bar[XB_TMO])) break; if (sp > XB_SPIN_CAP) { atomicAdd(&bar[XB_TMO], 1u); break; } }
    }
    nloc = mine > 0u ? mine : 1u; nx = cnt > 0u ? cnt : 1u;
}

__device__ __forceinline__ void xcd_barrier(const XcdBarrier& b) {
    asm volatile("s_waitcnt vmcnt(0)" ::: "memory");
    __syncthreads();
    if (threadIdx.x == 0) {
        unsigned* bar = b.bar;
        __builtin_amdgcn_s_waitcnt(0);
        unsigned nloc = b.st[0], nx = b.st[1];
        if (nloc == 0u) { xcd_barrier_complete(bar, b.x, nloc, nx); b.st[0] = nloc; b.st[1] = nx; }
        const unsigned old = xb_add(&bar[XB_XSUB(b.x)], 1u);
        const unsigned gen = old / nloc;
        if (old + 1u == (gen + 1u) * nloc) {
            __builtin_amdgcn_fence(__ATOMIC_RELEASE, "agent");
            asm volatile("s_waitcnt vmcnt(0)" ::: "memory");
            const unsigned og = xb_add(&bar[XB_TOP], 1u);
            const unsigned tg = og / nx;
            if (og + 1u == (tg + 1u) * nx) xb_add(&bar[XB_TOPGEN], 1u);
            else XB_SPIN(xb_ld(&bar[XB_TOPGEN]) == tg, bar);
            __builtin_amdgcn_fence(__ATOMIC_ACQUIRE, "agent");
            xb_add(&bar[XB_XGEN(b.x)], 1u);
            asm volatile("s_waitcnt vmcnt(0)" ::: "memory");
        } else {
            XB_SPIN(xb_ld(&bar[XB_XGEN(b.x)]) == gen, bar);
            __builtin_amdgcn_fence(__ATOMIC_ACQUIRE, "agent");
            asm volatile("s_waitcnt vmcnt(0)" ::: "memory");
        }
    }
    __syncthreads();
}

constexpr int CW_BAR = 4096;
constexpr int LDSCTL_OFF = 131072;

struct Args { const void* in[15]; float* out; unsigned char* ws; int ph_lo, ph_hi; };
constexpr int NPH = 7;

__global__ void __launch_bounds__(512, 2) mk_fwd(Args args) {
    extern __shared__ __attribute__((aligned(16))) unsigned char lds[];
    Frame F;
    F.lds = lds; F.tid = threadIdx.x; F.lane = F.tid & 63; F.wave = __builtin_amdgcn_readfirstlane(F.tid >> 6);
    F.G = gridDim.x; { const int bx = blockIdx.x; F.vcu = (F.G % 8 == 0) ? (bx % 8) * (F.G / 8) + bx / 8 : bx; }
    F.x = (const float*)args.in[0]; F.c = (const float*)args.in[1]; F.pos = (const int*)args.in[2]; F.w_ada = (const float*)args.in[3]; F.b_ada = (const float*)args.in[4];
    F.g_norm = (const float*)args.in[5]; F.w_in = (const float*)args.in[6]; F.w_dw = (const float*)args.in[7]; F.b_dw = (const float*)args.in[8];
    F.g_ln = (const float*)args.in[9]; F.b_ln = (const float*)args.in[10]; F.w_pw = (const float*)args.in[11]; F.b_pw = (const float*)args.in[12];
    F.w_out = (const float*)args.in[13]; F.g_final = (const float*)args.in[14];
    F.out = args.out; F.ws = args.ws;
    const int lo = args.ph_lo, hi = args.ph_hi;
    for (int u = F.tid; u < (LDS_BYTES - LDSCTL_OFF) / 4; u += 512) ((LAS unsigned*)((LAS unsigned char*)lds + LDSCTL_OFF))[u] = 0u;
    __syncthreads();
    XcdBarrier bar = xcd_barrier_post((unsigned*)(F.ws + WS_CTL) + CW_BAR, (volatile LAS unsigned*)((LAS unsigned char*)lds + LDSCTL_OFF) + 8);
#define IN(k) (lo <= (k) && (k) < hi)
#define SEAM(k) do { if (IN(k) && IN((k) + 1)) xcd_barrier(bar); } while (0)
    PG8_LAS unsigned char* ldsl = (PG8_LAS unsigned char*)lds;
    if (IN(0)) { p0_mod(F); p0_rope(F); p0_weights(F); }
    SEAM(0);
    if (IN(1)) p1_h(F);
    SEAM(1);
    if (IN(2)) {
        pg8::Gemm g{(const bf16*)(F.ws + WS_H), (const bf16*)(F.ws + WS_WIN), T_, DIN, D_}; pg8::StaticOrder S; S.init(T_, DIN, F.G, (int)blockIdx.x);
        EpiProj E{(bf16*)(F.ws + WS_U), (bf16*)(F.ws + WS_SGC), (bf16*)(F.ws + WS_Q), (bf16*)(F.ws + WS_K), (bf16*)(F.ws + WS_V), (bf16*)(F.ws + WS_SGA), (const float*)(F.ws + WS_ROPE), (float*)(F.ws + WS_KMEAN)};
        pg8::gemm_phase<EpiProj, pg8::StaticOrder, true, true>(ldsl, g, S, E, F.wave);
    }
    SEAM(2);
    if (IN(3)) {
        n3_conv(F);
        __syncthreads();
        const attn_body::AttnTensors AT{(const attn_body::bf16*)(F.ws + WS_Q), (const attn_body::bf16*)(F.ws + WS_K), (const attn_body::bf16*)(F.ws + WS_V), (attn_body::bf16*)(F.ws + WS_YCAT),
                                        (const attn_body::bf16*)(F.ws + WS_SGA), (const float*)(F.ws + WS_KMEAN)};
        const attn_body::StaticOrder S((int)F.G, (int)blockIdx.x);
        attn_body::attn_phase<attn_body::StaticOrder>((char*)lds, AT, S, F.wave);
    }
    SEAM(3);
    F.lane = mk_lane(); F.tid = F.wave * 64 + F.lane;
    if (IN(4)) {
        pg8::Gemm g{(const bf16*)(F.ws + WS_ALN), (const bf16*)(F.ws + WS_WPW), T_, DC, DC}; pg8::StaticOrder S; S.init(T_, DC, F.G, (int)blockIdx.x);
        EpiPw E{(bf16*)(F.ws + WS_YCAT), (const bf16*)(F.ws + WS_SGC), F.b_pw};
        pg8::gemm_phase<EpiPw, pg8::StaticOrder, true, true>(ldsl, g, S, E, F.wave);
    }
    SEAM(4);
    if (IN(5)) {
        pg8::Gemm g{(const bf16*)(F.ws + WS_YCAT), (const bf16*)(F.ws + WS_WOUT), T_, D_, D_}; pg8::StaticOrder S; S.init(T_, D_, F.G, (int)blockIdx.x);
        EpiOut E{F.out, F.x, (const float*)(F.ws + WS_MOD)};
        pg8::gemm_phase<EpiOut, pg8::StaticOrder, true, true>(ldsl, g, S, E, F.wave);
    }
    SEAM(5);
    if (IN(6)) p6_final(F);
#undef IN
#undef SEAM
}

extern "C" void kernel_launch(void* const* d_in, const int* in_sizes, int n_in, void* d_out, int out_size, void* d_ws, size_t ws_size, hipStream_t stream) {
    static int grid = 0;
    if (grid == 0) {
        if (n_in != 15 || out_size != T_ * D_ || ws_size < WS_END) { fprintf(stderr, "kernel_launch: unexpected problem (n_in %d out %d ws %zu)\n", n_in, out_size, ws_size); grid = -1; return; }
        int dev = 0, cus = 0, per_cu = 0;
        hipGetDevice(&dev); hipDeviceGetAttribute(&cus, hipDeviceAttributeMultiprocessorCount, dev);
        hipFuncSetAttribute((const void*)mk_fwd, hipFuncAttributeMaxDynamicSharedMemorySize, LDS_BYTES);
        hipOccupancyMaxActiveBlocksPerMultiprocessor(&per_cu, (const void*)mk_fwd, 512, LDS_BYTES);
        if (per_cu < 1) per_cu = 1;
        (void)hipGetLastError();
        grid = cus * per_cu;
    }
    if (grid < 0) return;
    hipMemsetAsync((char*)d_ws + WS_CTL, 0, CTL_ZERO, stream);
    Args a{};
    for (int i = 0; i < 15; ++i) a.in[i] = d_in[i];
    a.out = (float*)d_out; a.ws = (unsigned char*)d_ws;
    a.ph_lo = 0; a.ph_hi = NPH;
    void* kargs[] = {&a};
    hipError_t e = hipLaunchCooperativeKernel((const void*)mk_fwd, dim3(grid), dim3(512), kargs, LDS_BYTES, stream);
    if (e != hipSuccess) fprintf(stderr, "cooperative launch failed: %s (grid %d)\n", hipGetErrorString(e), grid);
}
```

```cpp
#include <hip/hip_runtime.h>
#include <hip/hip_cooperative_groups.h>
#include <cstdio>
#include <cstdint>
namespace cg = cooperative_groups;

constexpr int NB_ = 8, S_ = 4096, T_ = NB_ * S_, D_ = 1024, DIN = 3584, DC = 512, NH = 8, HD = 64, KB = 256, NKB = S_ / KB, CW = 31;
constexpr float EPS_ = 1e-6f;
constexpr float C2 = 0.125f * 1.4426950408889634f;

typedef unsigned short bf16;
typedef unsigned u32x4 __attribute__((ext_vector_type(4)));
typedef float f32x4 __attribute__((ext_vector_type(4)));

constexpr size_t MiB = 1u << 20;
constexpr size_t WS_CTL = 0;
constexpr size_t CTL_ZERO = 2 * MiB;
constexpr size_t WS_KMEAN = 1 * MiB;
constexpr size_t WS_MODP = 2 * MiB;
constexpr size_t WS_MOD = 2 * MiB + 512 * 1024;
constexpr size_t WS_ROPE = 3 * MiB;
constexpr size_t WS_WIN = 6 * MiB;
constexpr size_t WS_WPW = 13 * MiB;
constexpr size_t WS_WOUT = 14 * MiB;
constexpr size_t WS_H = 16 * MiB;
constexpr size_t WS_U = 80 * MiB;
constexpr size_t WS_SGC = 112 * MiB;
constexpr size_t WS_Q = 144 * MiB;
constexpr size_t WS_K = 176 * MiB;
constexpr size_t WS_V = 208 * MiB;
constexpr size_t WS_SGA = 240 * MiB;
constexpr size_t WS_ALN = 272 * MiB;
constexpr size_t WS_YCAT = 304 * MiB;
constexpr size_t WS_P = 272 * MiB;
constexpr size_t WS_END = 496 * MiB;

constexpr int LDS_BYTES = 147456;

__device__ __forceinline__ float bf2f(unsigned b) { return __uint_as_float(b << 16); }
__device__ __forceinline__ unsigned f2bf(float f) { unsigned u = __float_as_uint(f); return (u + 0x7fffu + ((u >> 16) & 1u)) >> 16; }
__device__ __forceinline__ unsigned pk2(float lo, float hi) { return f2bf(lo) | (f2bf(hi) << 16); }
__device__ __forceinline__ float silu_f(float v) { return v / (1.f + __expf(-v)); }
__device__ __forceinline__ float sigm_f(float v) { return 1.f / (1.f + __expf(-v)); }
__device__ __forceinline__ float wave_sum(float v) {
#pragma unroll
    for (int o = 1; o < 64; o <<= 1) v += __shfl_xor(v, o);
    return v;
}
__device__ __forceinline__ float wave_max(float v) {
#pragma unroll
    for (int o = 1; o < 64; o <<= 1) v = fmaxf(v, __shfl_xor(v, o));
    return v;
}
__device__ __forceinline__ void unpack8(const u32x4 v, float (&f)[8]) {
    f[0] = bf2f(v.x & 0xffffu); f[1] = bf2f(v.x >> 16); f[2] = bf2f(v.y & 0xffffu); f[3] = bf2f(v.y >> 16);
    f[4] = bf2f(v.z & 0xffffu); f[5] = bf2f(v.z >> 16); f[6] = bf2f(v.w & 0xffffu); f[7] = bf2f(v.w >> 16);
}
__device__ __forceinline__ u32x4 pack8(const float (&f)[8]) {
    u32x4 o; o.x = pk2(f[0], f[1]); o.y = pk2(f[2], f[3]); o.z = pk2(f[4], f[5]); o.w = pk2(f[6], f[7]); return o;
}

struct Frame {
    unsigned char* lds;
    int tid, lane, wave, vcu, G;
    const float *x, *c, *w_ada, *b_ada, *g_norm, *w_in, *w_dw, *b_dw, *g_ln, *b_ln, *w_pw, *b_pw, *w_out, *g_final;
    const int* pos;
    float* out; unsigned char* ws;
};

__device__ __forceinline__ int mk_lane() { int l = (int)__builtin_amdgcn_mbcnt_hi(~0u, __builtin_amdgcn_mbcnt_lo(~0u, 0u)); asm volatile("" : "+v"(l)); return l; }
namespace pg8 {
#define PG8_LAS __attribute__((address_space(3)))
typedef unsigned short bf16_t;
typedef short bf16x8 __attribute__((ext_vector_type(8)));
typedef float f32x4 __attribute__((ext_vector_type(4)));
typedef unsigned u32x4 __attribute__((ext_vector_type(4)));
constexpr int BM = 256, BK = 64, HALF = 128, HTB = HALF * BK * 2  , STAGE_BYTES = 8 * HTB, NXCD = 8, WGM = 8;

__host__ __device__ __forceinline__ int lds_byte(int r, int c) { const int st = (r >> 4) * 2 + (c >> 5), rr = r & 15, cc = c & 31, ob = rr * 64 + cc * 2; return st * 1024 + (ob ^ (((ob >> 9) & 1) << 5)); }
__host__ __device__ __forceinline__ void stage_rc(int b, int& R, int& C) { const int st = b / 1024, sb = b % 1024, swz = sb ^ (((sb >> 9) & 1) << 5); R = (st >> 1) * 16 + swz / 64; C = (st & 1) * 32 + (swz % 64) / 2; }
__host__ __device__ __forceinline__ int perm32(int rho) { const int n = rho >> 4, i = rho & 15; return 8 * (i >> 2) + 4 * n + (i & 3); }

struct Unit { int pm, pn; };
struct Gemm { const bf16_t* A; const bf16_t* Bt; int M, N, K; };

struct StaticOrder {
    int nM, nN, nwg, G, c;
    __host__ __device__ void init(int M, int N, int G_, int c_) { nM = M / BM; nN = N / BM; nwg = nM * nN; G = G_; c = c_; }
    __host__ __device__ bool next(int i, Unit& u) const {
        const long L = (long)i * G + c; if (L >= nwg) return false;
        int wgid = (int)L; { const int q = nwg / NXCD, r = nwg % NXCD, xcd = wgid % NXCD, off = wgid / NXCD; wgid = (xcd < r ? xcd * (q + 1) : r * (q + 1) + (xcd - r) * q) + off; }
        const int nig = WGM * nN, gid = wgid / nig, fm = gid * WGM, gsz = (nM - fm) < WGM ? (nM - fm) : WGM;
        u.pm = fm + ((wgid % nig) % gsz); u.pn = (wgid % nig) / gsz; return true;
    }
    __device__ __forceinline__ void a_ready(const Unit&) const {}
    __device__ __forceinline__ void done(const Unit&) const {}
};

__device__ __forceinline__ unsigned cvt_pk_bf16(float lo, float hi) { unsigned r; asm volatile("v_cvt_pk_bf16_f32 %0, %1, %2" : "=v"(r) : "v"(lo), "v"(hi)); return r; }
typedef float f32x2 __attribute__((ext_vector_type(2)));
template <class Epi, class Sched, bool ALIGN_EPI = false, bool SP2 = false>
__device__ __forceinline__ void gemm_phase(PG8_LAS unsigned char* lds, const Gemm g, const Sched& S, const Epi& E, int wave_s) {
    const int lane = mk_lane(), wid = __builtin_amdgcn_readfirstlane(wave_s), tid = wid * 64 + lane, wr = wid >> 2, wc = wid & 3, fr = lane & 15, fq = lane >> 4;
    const int K = g.K, nt = K / BK;
    unsigned voffA[2], voffB[2];
#pragma unroll
    for (int i = 0; i < 2; ++i) { int R, C; stage_rc(tid * 16 + i * 8192, R, C); const int Rb = Epi::PERM ? ((R & ~31) + perm32(R & 31)) : R;
        voffA[i] = (unsigned)(R * K + C) * 2u; voffB[i] = (unsigned)(Rb * K + C) * 2u; }
    const size_t kstep = (size_t)(BK * 2);
    const size_t hstep = (size_t)HALF * K * 2;
    const size_t tstep = 2 * hstep;
    const unsigned ldsw = (unsigned)wid * 1024u;
    const int aoff = lds_byte(wr * 64 + fr, fq * 8), boff = lds_byte(wc * 32 + fr, fq * 8);
#define PG8_SA(b, h) (((b) * 2 + (h)) * HTB)
#define PG8_SB(b, h) ((4 + (b) * 2 + (h)) * HTB)
#define PG8_STAGE(bufoff, gbase, voff) do { _Pragma("unroll") for (int _i = 0; _i < 2; ++_i) \
        __builtin_amdgcn_global_load_lds((const unsigned*)((const char*)(gbase) + (voff)[_i]), (PG8_LAS unsigned*)(lds + (bufoff) + ldsw + _i * 8192), 16, 0, 0); } while (0)
#define PG8_LDA(dst, b, h) do { _Pragma("unroll") for (int m = 0; m < 4; ++m) _Pragma("unroll") for (int k = 0; k < 2; ++k) dst[m][k] = *(const PG8_LAS bf16x8*)(lds + PG8_SA(b, h) + aoff + m * 2048 + k * 1024); } while (0)
#define PG8_LDB(dst, b, h) do { _Pragma("unroll") for (int n = 0; n < 2; ++n) _Pragma("unroll") for (int k = 0; k < 2; ++k) dst[n][k] = *(const PG8_LAS bf16x8*)(lds + PG8_SB(b, h) + boff + n * 2048 + k * 1024); } while (0)
#define PG8_MMA(ai, bj, At, Bt) do { __builtin_amdgcn_s_setprio(1); _Pragma("unroll") for (int m = 0; m < 4; ++m) _Pragma("unroll") for (int n = 0; n < 2; ++n) _Pragma("unroll") for (int k = 0; k < 2; ++k) \
        acc[ai][bj][m][n] = __builtin_amdgcn_mfma_f32_16x16x32_bf16(Bt[n][k], At[m][k], acc[ai][bj][m][n], 0, 0, 0); __builtin_amdgcn_s_setprio(0); } while (0)
#define PG8_WAIT_V(n) asm volatile("s_waitcnt vmcnt(" #n ")" ::: "memory")
#define PG8_WAIT_L(n) asm volatile("s_waitcnt lgkmcnt(" #n ")" ::: "memory")
#define PG8_BAR __builtin_amdgcn_s_barrier()
#define PG8_SCHED __builtin_amdgcn_sched_barrier(0)
    Unit cur, nxt; int ui = 0;
    if (!S.next(0, cur)) return;
    f32x4 acc[2][2][4][2];
#pragma unroll
    for (int a = 0; a < 2; ++a)
#pragma unroll
        for (int b = 0; b < 2; ++b)
#pragma unroll
            for (int m = 0; m < 4; ++m)
#pragma unroll
                for (int n = 0; n < 2; ++n) acc[a][b][m][n] = (f32x4){0.f, 0.f, 0.f, 0.f};
    bf16x8 At[4][2], B0[2][2], B1[2][2];
    const char* cA = (const char*)g.A + (size_t)cur.pm * tstep; const char* cB = (const char*)g.Bt + (size_t)cur.pn * tstep;
    S.a_ready(cur);
    if constexpr (SP2) {
        PG8_STAGE(PG8_SB(0, 0), cB, voffB); PG8_STAGE(PG8_SB(0, 1), cB + hstep, voffB); PG8_STAGE(PG8_SA(0, 0), cA, voffA); PG8_STAGE(PG8_SA(0, 1), cA + hstep, voffA);
        if (wr == 1) PG8_BAR;
        PG8_WAIT_V(2); PG8_BAR;
        PG8_STAGE(PG8_SB(1, 0), cB + kstep, voffB); PG8_STAGE(PG8_SA(1, 0), cA + kstep, voffA); PG8_STAGE(PG8_SB(1, 1), cB + hstep + kstep, voffB);
        PG8_WAIT_V(6); PG8_BAR;
    } else {
        PG8_STAGE(PG8_SB(0, 0), cB, voffB); PG8_STAGE(PG8_SA(0, 0), cA, voffA); PG8_STAGE(PG8_SB(0, 1), cB + hstep, voffB); PG8_STAGE(PG8_SA(0, 1), cA + hstep, voffA);
        if (wr == 1) PG8_BAR;
        PG8_WAIT_V(4); PG8_BAR;
        PG8_STAGE(PG8_SB(1, 0), cB + kstep, voffB); PG8_STAGE(PG8_SA(1, 0), cA + kstep, voffA); PG8_STAGE(PG8_SB(1, 1), cB + hstep + kstep, voffB);
        PG8_WAIT_V(6); PG8_BAR;
    }
    for (;;) {
        const bool has_next = S.next(ui + 1, nxt);
        const char* nA = has_next ? (const char*)g.A + (size_t)nxt.pm * tstep : cA; const char* nB = has_next ? (const char*)g.Bt + (size_t)nxt.pn * tstep : cB;
        for (int t = 0; t < nt; t += 2) {
            const bool last = (t == nt - 2);
            const char* a1 = cA + (size_t)(t + 1) * kstep;
            const char* a2 = last ? nA : cA + (size_t)(t + 2) * kstep; const char* b2 = last ? nB : cB + (size_t)(t + 2) * kstep;
            const char* a3 = a2 + kstep; const char* b3 = b2 + kstep;
            if (last && has_next) S.a_ready(nxt);
            if constexpr (SP2) {
            PG8_LDB(B0, 0, 0); PG8_LDB(B1, 0, 1); PG8_SCHED; PG8_LDA(At, 0, 0); PG8_STAGE(PG8_SA(1, 1), a1 + hstep, voffA);
            PG8_WAIT_V(8); PG8_WAIT_L(0); PG8_BAR; PG8_MMA(0, 0, At, B0); PG8_MMA(0, 1, At, B1); PG8_BAR; PG8_SCHED;
            PG8_LDA(At, 0, 1); PG8_STAGE(PG8_SB(0, 0), b2, voffB); PG8_STAGE(PG8_SB(0, 1), b2 + hstep, voffB); PG8_STAGE(PG8_SA(0, 0), a2, voffA);
            PG8_WAIT_V(8); PG8_WAIT_L(0); PG8_BAR; PG8_MMA(1, 0, At, B0); PG8_MMA(1, 1, At, B1); PG8_BAR; PG8_SCHED;
            PG8_LDB(B0, 1, 0); PG8_LDB(B1, 1, 1); PG8_SCHED; PG8_LDA(At, 1, 0); PG8_STAGE(PG8_SA(0, 1), a2 + hstep, voffA);
            PG8_WAIT_V(8); PG8_WAIT_L(0); PG8_BAR; PG8_MMA(0, 0, At, B0); PG8_MMA(0, 1, At, B1); PG8_BAR; PG8_SCHED;
            PG8_LDA(At, 1, 1); PG8_STAGE(PG8_SB(1, 0), b3, voffB); PG8_STAGE(PG8_SB(1, 1), b3 + hstep, voffB); PG8_STAGE(PG8_SA(1, 0), a3, voffA);
            PG8_WAIT_V(8); PG8_WAIT_L(0); PG8_BAR; PG8_MMA(1, 0, At, B0); PG8_MMA(1, 1, At, B1); PG8_BAR; PG8_SCHED;
            } else {
            PG8_LDB(B0, 0, 0); PG8_SCHED; PG8_LDA(At, 0, 0); PG8_STAGE(PG8_SA(1, 1), a1 + hstep, voffA);
            PG8_WAIT_L(8); PG8_BAR; PG8_WAIT_L(0); PG8_MMA(0, 0, At, B0); PG8_BAR; PG8_SCHED;
            PG8_LDB(B1, 0, 1); PG8_STAGE(PG8_SB(0, 0), b2, voffB);
            PG8_BAR; PG8_WAIT_L(0); PG8_MMA(0, 1, At, B1); PG8_BAR;
            PG8_LDA(At, 0, 1); PG8_STAGE(PG8_SA(0, 0), a2, voffA);
            PG8_BAR; PG8_WAIT_L(0); PG8_MMA(1, 0, At, B0); PG8_BAR; PG8_SCHED;
            PG8_STAGE(PG8_SB(0, 1), b2 + hstep, voffB);
            PG8_WAIT_V(6); PG8_BAR; PG8_MMA(1, 1, At, B1); PG8_BAR;
            PG8_LDB(B0, 1, 0); PG8_SCHED; PG8_LDA(At, 1, 0); PG8_STAGE(PG8_SA(0, 1), a2 + hstep, voffA);
            PG8_WAIT_L(8); PG8_BAR; PG8_WAIT_L(0); PG8_MMA(0, 0, At, B0); PG8_BAR; PG8_SCHED;
            PG8_LDB(B1, 1, 1); PG8_STAGE(PG8_SB(1, 0), b3, voffB);
            PG8_BAR; PG8_WAIT_L(0); PG8_MMA(0, 1, At, B1); PG8_BAR;
            PG8_LDA(At, 1, 1); PG8_STAGE(PG8_SA(1, 0), a3, voffA);
            PG8_BAR; PG8_WAIT_L(0); PG8_MMA(1, 0, At, B0); PG8_BAR; PG8_SCHED;
            PG8_STAGE(PG8_SB(1, 1), b3 + hstep, voffB);
            PG8_WAIT_V(6); PG8_BAR; PG8_MMA(1, 1, At, B1); PG8_BAR;
            }
        }
        if constexpr (ALIGN_EPI) { if (wr == 0) PG8_BAR; }
        if constexpr (!Epi::AFTER_DRAIN) { E(acc, cur, wr, wc, fr, fq); S.done(cur); }
        if (!has_next) break;
#pragma unroll
        for (int a = 0; a < 2; ++a)
#pragma unroll
            for (int b = 0; b < 2; ++b)
#pragma unroll
                for (int m = 0; m < 4; ++m)
#pragma unroll
                    for (int n = 0; n < 2; ++n) acc[a][b][m][n] = (f32x4){0.f, 0.f, 0.f, 0.f};
        cur = nxt; cA = nA; cB = nB; ++ui;
        if constexpr (ALIGN_EPI) { if (wr == 1) PG8_BAR; }
    }
    PG8_WAIT_V(0);
    if constexpr (!ALIGN_EPI) { if (wr == 0) PG8_BAR; }
    PG8_BAR;
    if constexpr (Epi::AFTER_DRAIN) { E.fused(acc, cur, wr, wc, fr, fq, lds, wid, lane); S.done(cur); }
#undef PG8_SA
#undef PG8_SB
#undef PG8_STAGE
#undef PG8_LDA
#undef PG8_LDB
#undef PG8_MMA
#undef PG8_WAIT_V
#undef PG8_WAIT_L
#undef PG8_BAR
#undef PG8_SCHED
}
}

__device__ __forceinline__ int colmap_in(int n) {
    const int tile = n >> 8, w = n & 255;
    if (tile < 4) return ((w >> 7) ? 512 : 0) + tile * 128 + (w & 127);
    if (tile >= 6 && tile < 10) { const int vd = n & 63; if (vd < 16) { const int g = vd >> 3, e = vd & 7; return (n & ~63) + ((e < 4) ? 4 * g + e : 8 + 4 * g + (e - 4)); } }
    return n;
}
__device__ __forceinline__ u32x4 pack2v(const f32x4 a, const f32x4 b) { u32x4 w; w.x = pg8::cvt_pk_bf16(a[0], a[1]); w.y = pg8::cvt_pk_bf16(a[2], a[3]); w.z = pg8::cvt_pk_bf16(b[0], b[1]); w.w = pg8::cvt_pk_bf16(b[2], b[3]); return w; }
__device__ __forceinline__ f32x4 sigm4(const f32x4 g) { f32x4 r; r.x = sigm_f(g.x); r.y = sigm_f(g.y); r.z = sigm_f(g.z); r.w = sigm_f(g.w); return r; }
struct EpiProj {
    static constexpr bool PERM = true, AFTER_DRAIN = false;
    bf16 *U, *SGC, *Q, *K, *V, *SGA; const float* ROPE; float* KM;
    __device__ __forceinline__ void operator()(const f32x4 (&acc)[2][2][4][2], const pg8::Unit& u, int wr, int wc, int fr, int fq) const {
        const int row0 = u.pm * 256 + wr * 64 + fr, colw = wc * 32 + 8 * fq, pn = u.pn;
        if (pn < 4) {
#pragma unroll
            for (int ai = 0; ai < 2; ++ai)
#pragma unroll
                for (int m = 0; m < 4; ++m) { const int row = row0 + ai * 128 + m * 16;
                    const f32x4 o0 = acc[ai][0][m][0] * sigm4(acc[ai][1][m][0]), o1 = acc[ai][0][m][1] * sigm4(acc[ai][1][m][1]);
                    *(u32x4*)(U + (size_t)row * DC + pn * 128 + colw) = pack2v(o0, o1); }
            return;
        }
        const int sec = (pn - 4) >> 1, cb = ((pn - 4) & 1) * 256;
        bf16* base = (sec == 0) ? SGC : (sec == 1) ? Q : (sec == 2) ? K : (sec == 3) ? V : SGA;
        const bool is_qk = (sec == 1 || sec == 2), rope_w = is_qk && !(wc & 1), rope_l = rope_w && fq < 2;
        f32x4 ks[2][2];
#pragma unroll
        for (int bj = 0; bj < 2; ++bj) { ks[bj][0] = (f32x4){0.f, 0.f, 0.f, 0.f}; ks[bj][1] = (f32x4){0.f, 0.f, 0.f, 0.f}; }
#pragma unroll
        for (int ai = 0; ai < 2; ++ai)
#pragma unroll
            for (int m = 0; m < 4; ++m) { const int row = row0 + ai * 128 + m * 16;
                f32x4 cs0 = (f32x4){1.f, 0.f, 1.f, 0.f}, cs1 = cs0;
                if (rope_w) { const f32x4* rp = (const f32x4*)(ROPE + ((size_t)row * 8 + 4 * (fq & 1)) * 2); cs0 = rp[0]; cs1 = rp[1]; }
#pragma unroll
                for (int bj = 0; bj < 2; ++bj) { f32x4 v0 = acc[ai][bj][m][0], v1 = acc[ai][bj][m][1];
                    if (sec == 0 || sec == 4) { v0 = v0 * sigm4(v0); v1 = v1 * sigm4(v1); }
                    else if (is_qk) {
                        if (rope_w) { const f32x4 co = (f32x4){cs0.x, cs0.z, cs1.x, cs1.z}, si = (f32x4){cs0.y, cs0.w, cs1.y, cs1.w};
                            const f32x4 r1 = v0 * co - v1 * si, r2 = v1 * co + v0 * si;
                            if (rope_l) { v0 = r1; v1 = r2; } }
                        if (sec == 1) { v0 = v0 * C2; v1 = v1 * C2; } else { ks[bj][0] += v0; ks[bj][1] += v1; }
                    }
                    *(u32x4*)(base + (size_t)row * DC + cb + bj * 128 + colw) = pack2v(v0, v1); } }
        if (sec == 2) {
            const int b = u.pm >> 4, blk = u.pm & 15;
#pragma unroll
            for (int bj = 0; bj < 2; ++bj)
#pragma unroll
                for (int n = 0; n < 2; ++n)
#pragma unroll
                    for (int e = 0; e < 4; ++e) { float s = ks[bj][n][e];
                        s += __shfl_xor(s, 1); s += __shfl_xor(s, 2); s += __shfl_xor(s, 4); s += __shfl_xor(s, 8);
                        if (fr == 0) { const int kc = cb + bj * 128 + colw + 4 * n + e; atomicAdd(KM + (((size_t)b * NH + (kc >> 6)) * NKB + blk) * HD + (kc & 63), s * (1.f / KB)); } }
        }
    }
};
struct EpiPw {
    static constexpr bool PERM = true, AFTER_DRAIN = false;
    bf16* Y; const bf16* SGC; const float* bias;
    __device__ __forceinline__ void operator()(const f32x4 (&acc)[2][2][4][2], const pg8::Unit& u, int wr, int wc, int fr, int fq) const {
        const int row0 = u.pm * 256 + wr * 64 + fr, col0 = u.pn * 256 + wc * 32 + 8 * fq;
        f32x4 bv[2][2];
#pragma unroll
        for (int bj = 0; bj < 2; ++bj) { bv[bj][0] = *(const f32x4*)(bias + col0 + bj * 128); bv[bj][1] = *(const f32x4*)(bias + col0 + bj * 128 + 4); }
#pragma unroll
        for (int ai = 0; ai < 2; ++ai)
#pragma unroll
            for (int m = 0; m < 4; ++m) { const int row = row0 + ai * 128 + m * 16;
#pragma unroll
                for (int bj = 0; bj < 2; ++bj) { float g[8]; unpack8(*(const u32x4*)(SGC + (size_t)row * DC + col0 + bj * 128), g);
                    const f32x4 v0 = (acc[ai][bj][m][0] + bv[bj][0]) * (f32x4){g[0], g[1], g[2], g[3]}, v1 = (acc[ai][bj][m][1] + bv[bj][1]) * (f32x4){g[4], g[5], g[6], g[7]};
                    *(u32x4*)(Y + (size_t)row * D_ + col0 + bj * 128) = pack2v(v0, v1); } }
    }
};
struct EpiOut {
    static constexpr bool PERM = false, AFTER_DRAIN = false;
    float* O; const float* x; const float* MOD;
    __device__ __forceinline__ void operator()(const f32x4 (&acc)[2][2][4][2], const pg8::Unit& u, int wr, int wc, int fr, int fq) const {
        const int row0 = u.pm * 256 + wr * 64 + fr, col0 = u.pn * 256 + wc * 32 + 4 * fq, b = u.pm >> 4;
        f32x4 gv[2][2];
#pragma unroll
        for (int bj = 0; bj < 2; ++bj)
#pragma unroll
            for (int n = 0; n < 2; ++n) gv[bj][n] = *(const f32x4*)(MOD + (size_t)b * 3072 + 2048 + col0 + bj * 128 + n * 16);
#pragma unroll
        for (int ai = 0; ai < 2; ++ai)
#pragma unroll
            for (int m = 0; m < 4; ++m) { const size_t off = (size_t)(row0 + ai * 128 + m * 16) * D_ + col0;
#pragma unroll
                for (int bj = 0; bj < 2; ++bj)
#pragma unroll
                    for (int n = 0; n < 2; ++n) { const f32x4 xv = *(const f32x4*)(x + off + bj * 128 + n * 16);
                        *(f32x4*)(O + off + bj * 128 + n * 16) = xv + gv[bj][n] * acc[ai][bj][m][n]; } }
    }
};

template <bool MAP>
__device__ __forceinline__ void p0_transpose_item(const float* W, int K, int N, bf16* WT, float* scr, int item, int lane) {
    const int nblk = N / 32, kb = item / nblk, nb = item % nblk, k0 = 64 * kb, n0 = 32 * nb;
    const int ncol = MAP ? colmap_in(n0 + (lane & 31)) : n0 + (lane & 31);
#pragma unroll 8
    for (int i = 0; i < 32; ++i) { const int kk = 2 * i + (lane >> 5); scr[kk * 33 + (lane & 31)] = W[(size_t)(k0 + kk) * N + ncol]; }
    __builtin_amdgcn_s_waitcnt(0); __builtin_amdgcn_wave_barrier();
    const int c = lane & 7;
#pragma unroll
    for (int j = 0; j < 4; ++j) { const int n = (lane >> 3) + 8 * j; const float* s = scr + (8 * c) * 33 + n;
        u32x4 o; o.x = pk2(s[0 * 33], s[1 * 33]); o.y = pk2(s[2 * 33], s[3 * 33]); o.z = pk2(s[4 * 33], s[5 * 33]); o.w = pk2(s[6 * 33], s[7 * 33]);
        *(u32x4*)(WT + (size_t)(n0 + n) * K + k0 + 8 * c) = o; }
    __builtin_amdgcn_s_waitcnt(0); __builtin_amdgcn_wave_barrier();
}

__device__ __forceinline__ void p0_mod(Frame& F) {
    float* red = (float*)F.lds;
    float* MODP = (float*)(F.ws + WS_MODP);
    for (int it = F.vcu; it < 48 * 4; it += F.G) {
        const int cc = it % 48, q = it / 48, n = cc * 64 + F.lane, k0 = q * 256 + F.wave * 32;
        float acc[8];
#pragma unroll
        for (int b = 0; b < 8; ++b) acc[b] = 0.f;
#pragma unroll 8
        for (int kk = 0; kk < 32; ++kk) {
            const float w = F.w_ada[(size_t)(k0 + kk) * 3072 + n];
#pragma unroll
            for (int b = 0; b < 8; ++b) { const float cv = F.c[b * D_ + k0 + kk]; acc[b] += silu_f(cv) * w; }
        }
        __syncthreads();
#pragma unroll
        for (int b = 0; b < 8; ++b) red[(F.wave * 8 + b) * 64 + F.lane] = acc[b];
        __syncthreads();
        {
            float s = 0.f;
#pragma unroll
            for (int w = 0; w < 8; ++w) s += red[(w * 8 + F.wave) * 64 + F.lane];
            MODP[((size_t)q * 8 + F.wave) * 3072 + n] = s;
        }
    }
    __syncthreads();
}
__device__ __forceinline__ void p0_rope(Frame& F) {
    float* ROPE = (float*)(F.ws + WS_ROPE);
    const int gt = F.vcu * 512 + F.tid, NT = F.G * 512;
    for (int e = gt; e < T_ * 8; e += NT) {
        const int t = e >> 3, i = e & 7;
        const double inv = (i == 0) ? 1.0 : (i == 1) ? 0.19392274474868576 : (i == 2) ? 0.03760603093086393 : (i == 3) ? 0.007292664737217109 :
                           (i == 4) ? 0.001414213562373095 : (i == 5) ? 0.0002742481756762073 : (i == 6) ? 5.318295896944988e-05 : 1.031338537721246e-05;
        const double rev = (double)F.pos[t] * inv * 0.15915494309189535;
        const float fr = (float)(rev - floor(rev));
        ROPE[2 * e] = __builtin_amdgcn_cosf(fr); ROPE[2 * e + 1] = __builtin_amdgcn_sinf(fr);
    }
}
__device__ __forceinline__ void p0_weights(Frame& F) {
    float* scr = (float*)(F.lds + 16384 + F.wave * 9216);
    const int gw = F.vcu * 8 + F.wave, NGW = F.G * 8;
    constexpr int I_IN = (D_ / 64) * (DIN / 32), I_PW = (DC / 64) * (DC / 32), I_OUT = (D_ / 64) * (D_ / 32);
    for (int it = gw; it < I_IN + I_PW + I_OUT; it += NGW) {
        int r = it;
        if (r < I_IN) { p0_transpose_item<true>(F.w_in, D_, DIN, (bf16*)(F.ws + WS_WIN), scr, r, F.lane); continue; } r -= I_IN;
        if (r < I_PW) { p0_transpose_item<false>(F.w_pw, DC, DC, (bf16*)(F.ws + WS_WPW), scr, r, F.lane); continue; } r -= I_PW;
        p0_transpose_item<false>(F.w_out, D_, D_, (bf16*)(F.ws + WS_WOUT), scr, r, F.lane);
    }
}
__device__ __forceinline__ float mod_at(Frame& F, int b, int n) {
    const float* MODP = (const float*)(F.ws + WS_MODP);
    float s = F.b_ada[n];
#pragma unroll
    for (int q = 0; q < 4; ++q) s += MODP[((size_t)q * 8 + b) * 3072 + n];
    return s;
}

__device__ __forceinline__ void p1_h(Frame& F) {
    bf16* Hb = (bf16*)(F.ws + WS_H);
    { float* MOD = (float*)(F.ws + WS_MOD); for (int e = F.vcu * 512 + F.tid; e < NB_ * 3072; e += F.G * 512) MOD[e] = mod_at(F, e / 3072, e % 3072); }
    const int gw = F.vcu * 8 + F.wave, NGW = F.G * 8, RPW = 16;
    for (int blk = gw; blk < T_ / RPW; blk += NGW) {
        const int r0 = blk * RPW, b = r0 / S_;
        f32x4 gs[4], sh[4];
#pragma unroll
        for (int j = 0; j < 4; ++j) {
            const int k = 4 * F.lane + 256 * j;
            float g4[4], s4[4];
#pragma unroll
            for (int e = 0; e < 4; ++e) { g4[e] = F.g_norm[k + e] * (1.f + mod_at(F, b, 1024 + k + e)); s4[e] = mod_at(F, b, k + e); }
            gs[j] = (f32x4){g4[0], g4[1], g4[2], g4[3]}; sh[j] = (f32x4){s4[0], s4[1], s4[2], s4[3]};
        }
        for (int r = r0; r < r0 + RPW; ++r) {
            const f32x4* xr = (const f32x4*)(F.x + (size_t)r * D_) + F.lane;
            f32x4 v[4]; float s = 0.f;
#pragma unroll
            for (int j = 0; j < 4; ++j) { v[j] = xr[64 * j]; s += (v[j].x * v[j].x + v[j].y * v[j].y) + (v[j].z * v[j].z + v[j].w * v[j].w); }
            const float rstd = rsqrtf(wave_sum(s) * (1.f / D_) + EPS_);
            unsigned long long* o8 = (unsigned long long*)(Hb + (size_t)r * D_) + F.lane;
#pragma unroll
            for (int j = 0; j < 4; ++j) { const f32x4 h = v[j] * rstd * gs[j] + sh[j];
                o8[64 * j] = (unsigned long long)pk2(h.x, h.y) | ((unsigned long long)pk2(h.z, h.w) << 32); }
        }
    }
}

template <class Epi>
__device__ __forceinline__ void naive_gemm(Frame& F, const bf16* A, int lda, const float* W, int M, int N, int K, const Epi& epi) {
    float* As = (float*)F.lds;
    float* Bs = As + 32 * 132;
    const int tid = F.tid, ty = tid >> 4, tx = tid & 15;
    const int ntn = N / 128, ntiles = (M / 128) * ntn;
    const int arow = tid >> 2, akq = (tid & 3) * 8, bkk = tid >> 4, bn8 = (tid & 15) * 8;
    for (int tile = F.vcu; tile < ntiles; tile += F.G) {
        const int tm = tile / ntn, tn = tile % ntn;
        float acc[4][8];
#pragma unroll
        for (int i = 0; i < 4; ++i)
#pragma unroll
            for (int j = 0; j < 8; ++j) acc[i][j] = 0.f;
        for (int k0 = 0; k0 < K; k0 += 32) {
            const u32x4 av = *(const u32x4*)(A + (size_t)(tm * 128 + arow) * lda + k0 + akq);
            const f32x4 b0 = *(const f32x4*)(W + (size_t)(k0 + bkk) * N + tn * 128 + bn8);
            const f32x4 b1 = *(const f32x4*)(W + (size_t)(k0 + bkk) * N + tn * 128 + bn8 + 4);
            __syncthreads();
            float af[8]; unpack8(av, af);
#pragma unroll
            for (int i = 0; i < 8; ++i) As[(akq + i) * 132 + arow] = af[i];
            *(f32x4*)&Bs[bkk * 132 + bn8] = b0; *(f32x4*)&Bs[bkk * 132 + bn8 + 4] = b1;
            __syncthreads();
#pragma unroll 8
            for (int kk = 0; kk < 32; ++kk) {
                const f32x4 a4 = *(const f32x4*)&As[kk * 132 + ty * 4];
                const f32x4 c0 = *(const f32x4*)&Bs[kk * 132 + tx * 8], c1 = *(const f32x4*)&Bs[kk * 132 + tx * 8 + 4];
                const float a[4] = {a4.x, a4.y, a4.z, a4.w}; const float bb[8] = {c0.x, c0.y, c0.z, c0.w, c1.x, c1.y, c1.z, c1.w};
#pragma unroll
                for (int i = 0; i < 4; ++i)
#pragma unroll
                    for (int j = 0; j < 8; ++j) acc[i][j] += a[i] * bb[j];
            }
        }
#pragma unroll
        for (int i = 0; i < 4; ++i) epi(tm * 128 + ty * 4 + i, tn * 128 + tx * 8, acc[i]);
    }
    __syncthreads();
}
struct EpiStoreBf16 { bf16* O; int ldc;
    __device__ __forceinline__ void operator()(int row, int col, const float (&v)[8]) const { *(u32x4*)(O + (size_t)row * ldc + col) = pack8(v); } };
struct EpiPwNaive { bf16* O; const bf16* SGC; const float* bias;
    __device__ __forceinline__ void operator()(int row, int col, const float (&v)[8]) const {
        float g[8], o[8]; unpack8(*(const u32x4*)(SGC + (size_t)row * DC + col), g);
#pragma unroll
        for (int j = 0; j < 8; ++j) o[j] = (v[j] + bias[col + j]) * g[j];
        *(u32x4*)(O + (size_t)row * D_ + col) = pack8(o); } };
struct EpiOutNaive { float* O; const float* x; const float* modp; const float* b_ada;
    __device__ __forceinline__ void operator()(int row, int col, const float (&v)[8]) const {
        const int b = row / S_;
#pragma unroll
        for (int j = 0; j < 8; ++j) { float g = b_ada[2048 + col + j];
#pragma unroll
            for (int q = 0; q < 4; ++q) g += modp[((size_t)q * 8 + b) * 3072 + 2048 + col + j];
            O[(size_t)row * D_ + col + j] = x[(size_t)row * D_ + col + j] + g * v[j]; } } };

__device__ __forceinline__ void n2_transform(Frame& F) {
    const bf16* P = (const bf16*)(F.ws + WS_P); const float* ROPE = (const float*)(F.ws + WS_ROPE);
    bf16 *U = (bf16*)(F.ws + WS_U), *SGC = (bf16*)(F.ws + WS_SGC), *Q = (bf16*)(F.ws + WS_Q), *K = (bf16*)(F.ws + WS_K), *V = (bf16*)(F.ws + WS_V), *SGA = (bf16*)(F.ws + WS_SGA);
    const int gw = F.vcu * 8 + F.wave, NGW = F.G * 8, c8 = F.lane * 8;
    for (int t = gw; t < T_; t += NGW) {
        const bf16* pr = P + (size_t)t * DIN;
        float a[8], g[8], o[8];
        unpack8(*(const u32x4*)(pr + c8), a); unpack8(*(const u32x4*)(pr + 512 + c8), g);
#pragma unroll
        for (int j = 0; j < 8; ++j) o[j] = a[j] * sigm_f(g[j]);
        *(u32x4*)(U + (size_t)t * DC + c8) = pack8(o);
        unpack8(*(const u32x4*)(pr + 1024 + c8), a);
#pragma unroll
        for (int j = 0; j < 8; ++j) o[j] = silu_f(a[j]);
        *(u32x4*)(SGC + (size_t)t * DC + c8) = pack8(o);
        float cs[8], sn[8];
#pragma unroll
        for (int j = 0; j < 8; ++j) { cs[j] = ROPE[((size_t)t * 8 + j) * 2]; sn[j] = ROPE[((size_t)t * 8 + j) * 2 + 1]; }
#pragma unroll
        for (int which = 0; which < 2; ++which) {
            unpack8(*(const u32x4*)(pr + (which ? 2048 : 1536) + c8), a);
            float p[8];
#pragma unroll
            for (int j = 0; j < 8; ++j) p[j] = __shfl_xor(a[j], 1);
            const int l7 = F.lane & 7;
#pragma unroll
            for (int j = 0; j < 8; ++j) { float r = a[j];
                if (l7 == 0) r = a[j] * cs[j] - p[j] * sn[j];
                else if (l7 == 1) r = a[j] * cs[j] + p[j] * sn[j];
                o[j] = which ? r : r * C2; }
            *(u32x4*)((which ? K : Q) + (size_t)t * DC + c8) = pack8(o);
        }
        *(u32x4*)(V + (size_t)t * DC + c8) = *(const u32x4*)(pr + 2560 + c8);
        unpack8(*(const u32x4*)(pr + 3072 + c8), a);
#pragma unroll
        for (int j = 0; j < 8; ++j) o[j] = silu_f(a[j]);
        *(u32x4*)(SGA + (size_t)t * DC + c8) = pack8(o);
    }
}
__device__ __forceinline__ void n2_kmean(Frame& F) {
    const bf16* K = (const bf16*)(F.ws + WS_K); float* KM = (float*)(F.ws + WS_KMEAN);
    const int gt = F.vcu * 512 + F.tid, NT = F.G * 512;
    for (int e = gt; e < NB_ * NKB * DC; e += NT) {
        const int col = e % DC, blk = (e / DC) % NKB, b = e / (DC * NKB);
        float s = 0.f;
        for (int r = 0; r < KB; ++r) s += bf2f(K[(size_t)(b * S_ + blk * KB + r) * DC + col]);
        KM[(((size_t)b * NH + col / HD) * NKB + blk) * HD + (col % HD)] = s * (1.f / KB);
    }
}

__device__ __forceinline__ void n3_conv(Frame& F) {
    const bf16* U = (const bf16*)(F.ws + WS_U); bf16* ALN = (bf16*)(F.ws + WS_ALN);
    const int gw = F.vcu * 8 + F.wave, NGW = F.G * 8, c8 = F.lane * 8;
    for (int t = gw; t < T_; t += NGW) {
        const int s = t % S_;
        float acc[8];
        { const f32x4 b0 = *(const f32x4*)(F.b_dw + c8), b1 = *(const f32x4*)(F.b_dw + c8 + 4);
          acc[0] = b0.x; acc[1] = b0.y; acc[2] = b0.z; acc[3] = b0.w; acc[4] = b1.x; acc[5] = b1.y; acc[6] = b1.z; acc[7] = b1.w; }
        for (int w = 0; w < CW; ++w) {
            const int sp = s - (CW - 1) + w;
            if (sp < 0) continue;
            float u[8]; unpack8(*(const u32x4*)(U + (size_t)(t - (CW - 1) + w) * DC + c8), u);
            const f32x4 k0 = *(const f32x4*)(F.w_dw + w * DC + c8), k1 = *(const f32x4*)(F.w_dw + w * DC + c8 + 4);
            acc[0] += u[0] * k0.x; acc[1] += u[1] * k0.y; acc[2] += u[2] * k0.z; acc[3] += u[3] * k0.w;
            acc[4] += u[4] * k1.x; acc[5] += u[5] * k1.y; acc[6] += u[6] * k1.z; acc[7] += u[7] * k1.w;
        }
        float sm = 0.f;
#pragma unroll
        for (int j = 0; j < 8; ++j) sm += acc[j];
        const float mu = wave_sum(sm) * (1.f / DC);
        float sq = 0.f;
#pragma unroll
        for (int j = 0; j < 8; ++j) { acc[j] -= mu; sq += acc[j] * acc[j]; }
        const float rstd = rsqrtf(wave_sum(sq) * (1.f / DC) + EPS_);
        float o[8];
#pragma unroll
        for (int j = 0; j < 8; ++j) o[j] = silu_f(acc[j] * rstd * F.g_ln[c8 + j] + F.b_ln[c8 + j]);
        *(u32x4*)(ALN + (size_t)t * DC + c8) = pack8(o);
    }
}

__device__ __forceinline__ void p3_conv(Frame& F, __attribute__((address_space(3))) unsigned char* ldsl) {
    typedef float f32x2_ __attribute__((ext_vector_type(2)));
    const unsigned* U32 = (const unsigned*)(F.ws + WS_U); bf16* ALN = (bf16*)(F.ws + WS_ALN);
    __attribute__((address_space(3))) float* tile = (__attribute__((address_space(3))) float*)ldsl;
    const int grp = F.tid >> 8, c = F.tid & 255;
    float k0[CW], k1[CW];
#pragma unroll
    for (int w = 0; w < CW; ++w) { const f32x2_ kw = *(const f32x2_*)(F.w_dw + w * DC + 2 * c); k0[w] = kw.x; k1[w] = kw.y; }
    const f32x2_ bb = *(const f32x2_*)(F.b_dw + 2 * c);
    for (int item = F.vcu; item < T_ / 64; item += F.G) {
        const int t0 = item * 64 + grp * 32, s0 = t0 % S_;
        unsigned in[38];
        if (s0 == 0) {
#pragma unroll
            for (int i = 0; i < 30; ++i) in[i] = 0u;
        } else {
#pragma unroll
            for (int i = 0; i < 30; ++i) in[i] = U32[(size_t)(t0 - 30 + i) * (DC / 2) + c];
        }
#pragma unroll 1
        for (int blk = 0; blk < 4; ++blk) {
#pragma unroll
            for (int i = 0; i < 8; ++i) in[30 + i] = U32[(size_t)(t0 + blk * 8 + i) * (DC / 2) + c];
            float a0[8], a1[8];
#pragma unroll
            for (int o = 0; o < 8; ++o) { a0[o] = bb.x; a1[o] = bb.y; }
#pragma unroll
            for (int w = 0; w < CW; ++w)
#pragma unroll
                for (int o = 0; o < 8; ++o) { a0[o] = __builtin_fmaf(__uint_as_float(in[o + w] << 16), k0[w], a0[o]); a1[o] = __builtin_fmaf(__uint_as_float(in[o + w] & 0xffff0000u), k1[w], a1[o]); }
#pragma unroll
            for (int o = 0; o < 8; ++o) *(__attribute__((address_space(3))) f32x2_*)(tile + (grp * 32 + blk * 8 + o) * DC + 2 * c) = (f32x2_){a0[o], a1[o]};
#pragma unroll
            for (int i = 0; i < 30; ++i) in[i] = in[i + 8];
        }
        __syncthreads();
        const int c8 = F.lane * 8;
        for (int tk = F.wave; tk < 64; tk += 8) {
            const __attribute__((address_space(3))) float* row = tile + tk * DC + c8;
            const f32x4 v0 = *(const __attribute__((address_space(3))) f32x4*)row, v1 = *(const __attribute__((address_space(3))) f32x4*)(row + 4);
            float a[8] = {v0.x, v0.y, v0.z, v0.w, v1.x, v1.y, v1.z, v1.w};
            float sm = 0.f;
#pragma unroll
            for (int j = 0; j < 8; ++j) sm += a[j];
            const float mu = wave_sum(sm) * (1.f / DC);
            float sq = 0.f;
#pragma unroll
            for (int j = 0; j < 8; ++j) { a[j] -= mu; sq += a[j] * a[j]; }
            const float rstd = rsqrtf(wave_sum(sq) * (1.f / DC) + EPS_);
            const f32x4 g0 = *(const f32x4*)(F.g_ln + c8), g1 = *(const f32x4*)(F.g_ln + c8 + 4), b0 = *(const f32x4*)(F.b_ln + c8), b1 = *(const f32x4*)(F.b_ln + c8 + 4);
            const float gg[8] = {g0.x, g0.y, g0.z, g0.w, g1.x, g1.y, g1.z, g1.w}, bv[8] = {b0.x, b0.y, b0.z, b0.w, b1.x, b1.y, b1.z, b1.w};
            float o[8];
#pragma unroll
            for (int j = 0; j < 8; ++j) o[j] = silu_f(a[j] * rstd * gg[j] + bv[j]);
            *(u32x4*)(ALN + (size_t)(item * 64 + tk) * DC + c8) = pack8(o);
        }
        __syncthreads();
    }
}

__device__ __forceinline__ void n3_attn(Frame& F) {
    const bf16 *Q = (const bf16*)(F.ws + WS_Q), *K = (const bf16*)(F.ws + WS_K), *V = (const bf16*)(F.ws + WS_V), *SGA = (const bf16*)(F.ws + WS_SGA);
    const float* KM = (const float*)(F.ws + WS_KMEAN); bf16* Y = (bf16*)(F.ws + WS_YCAT);
    float* qs = (float*)F.lds + F.wave * 64;
    float* ps = (float*)F.lds + 512 + F.wave * 1024;
    const int gw = F.vcu * 8 + F.wave, NGW = F.G * 8, lane = F.lane;
    for (int it = gw; it < T_ * NH; it += NGW) {
        const int h = it % NH, t = it / NH, b = t / S_, s = t % S_, qb = s / KB;
        const float qv = bf2f(Q[(size_t)t * DC + h * HD + lane]);
        qs[lane] = qv;
        __builtin_amdgcn_s_waitcnt(0); __builtin_amdgcn_wave_barrier();
        float gate = -3.0e38f;
        if (lane < qb) { const float* km = KM + (((size_t)b * NH + h) * NKB + lane) * HD; float g = 0.f;
            for (int d = 0; d < HD; ++d) g += qs[d] * km[d];
            gate = g; }
        int sel0 = -1, sel1 = -1, sel2 = -1;
        {
            float g0 = -3.0e38f, g1 = -3.0e38f, g2 = -3.0e38f;
            for (int j = 0; j < NKB; ++j) { const float gj = __shfl(gate, j);
                if (j < qb) {
                    if (gj > g0) { g2 = g1; sel2 = sel1; g1 = g0; sel1 = sel0; g0 = gj; sel0 = j; }
                    else if (gj > g1) { g2 = g1; sel2 = sel1; g1 = gj; sel1 = j; }
                    else if (gj > g2) { g2 = gj; sel2 = j; } } }
        }
        float lg[4][4]; float mx = -3.0e38f;
#pragma unroll
        for (int sl = 0; sl < 4; ++sl) {
            const int blk = (sl == 0) ? qb : (sl == 1) ? sel0 : (sl == 2) ? sel1 : sel2;
#pragma unroll
            for (int kk = 0; kk < 4; ++kk) {
                const int key = lane + 64 * kk; float l = -3.0e38f;
                if (blk >= 0 && (sl > 0 || blk * KB + key <= s)) {
                    const bf16* kr = K + (size_t)(b * S_ + blk * KB + key) * DC + h * HD; float a = 0.f;
#pragma unroll
                    for (int d8 = 0; d8 < 8; ++d8) { float kf[8]; unpack8(*(const u32x4*)(kr + d8 * 8), kf);
#pragma unroll
                        for (int e = 0; e < 8; ++e) a += qs[d8 * 8 + e] * kf[e]; }
                    l = a; }
                lg[sl][kk] = l; mx = fmaxf(mx, l);
            }
        }
        mx = wave_max(mx);
        float sum = 0.f;
#pragma unroll
        for (int sl = 0; sl < 4; ++sl)
#pragma unroll
            for (int kk = 0; kk < 4; ++kk) { const float p = (lg[sl][kk] > -1.0e38f) ? exp2f(lg[sl][kk] - mx) : 0.f; sum += p; ps[sl * 256 + lane + 64 * kk] = bf2f(f2bf(p)); }
        sum = wave_sum(sum);
        __builtin_amdgcn_s_waitcnt(0); __builtin_amdgcn_wave_barrier();
        float o = 0.f;
#pragma unroll
        for (int sl = 0; sl < 4; ++sl) {
            const int blk = (sl == 0) ? qb : (sl == 1) ? sel0 : (sl == 2) ? sel1 : sel2;
            if (blk < 0) continue;
            const int nk = (sl == 0) ? (s - qb * KB + 1) : KB;
            const bf16* vr = V + (size_t)(b * S_ + blk * KB) * DC + h * HD + lane;
            for (int key = 0; key < nk; ++key) o += ps[sl * 256 + key] * bf2f(vr[(size_t)key * DC]);
        }
        const float y = o / sum * bf2f(SGA[(size_t)t * DC + h * HD + lane]);
        Y[(size_t)t * D_ + DC + h * HD + lane] = (bf16)f2bf(y);
        __builtin_amdgcn_s_waitcnt(0); __builtin_amdgcn_wave_barrier();
    }
}

__device__ __forceinline__ void p6_final(Frame& F) {
    const int gw = F.vcu * 8 + F.wave, NGW = F.G * 8;
    f32x4 g[4];
#pragma unroll
    for (int j = 0; j < 4; ++j) g[j] = *((const f32x4*)F.g_final + F.lane + 64 * j);
    for (int r = gw; r < T_; r += NGW) {
        f32x4* xr = (f32x4*)(F.out + (size_t)r * D_) + F.lane;
        f32x4 v[4]; float s = 0.f;
#pragma unroll
        for (int j = 0; j < 4; ++j) { v[j] = xr[64 * j]; s += (v[j].x * v[j].x + v[j].y * v[j].y) + (v[j].z * v[j].z + v[j].w * v[j].w); }
        const float rstd = rsqrtf(wave_sum(s) * (1.f / D_) + EPS_);
#pragma unroll
        for (int j = 0; j < 4; ++j) xr[64 * j] = v[j] * rstd * g[j];
    }
}

#include <hip/hip_bf16.h>
#include <cmath>
namespace attn_body {
using bf16=__hip_bfloat16;
using bf16x8=__attribute__((ext_vector_type(8)))short;
using s16x4=__attribute__((ext_vector_type(4)))short;
using f32x16=__attribute__((ext_vector_type(16)))float;
using u32x4=__attribute__((ext_vector_type(4)))unsigned;
constexpr int BATCH=8,NHEAD=8,SEQ=4096,D=64,DM=NHEAD*D,YP=1024,YOFF=512;
constexpr int NW=8,QBLK=32,QB=QBLK*NW,KVBLK=64,NQB=SEQ/QB;
constexpr int ATTN_PITCH=DM, ATTN_UNIT_ROWS=QB;
__device__ __forceinline__ int crow(int r,int hi){return (r&3)+8*(r>>2)+4*hi;}
#define SBAR() __builtin_amdgcn_sched_barrier(0)
__device__ __forceinline__ void cmask(f32x16&p0,f32x16&p1,int jb,int qrel,int hi){
  const float NEG=-INFINITY; int kb=64*jb+4*hi;
  #pragma unroll
  for(int r=0;r<16;++r){int kv=kb+(r&3)+8*(r>>2); if(kv>qrel)p0[r]=NEG; if(kv+32>qrel)p1[r]=NEG;}
}

constexpr int NSLOT=3, SLOTB=8192;
constexpr int LDS_K=0, LDS_V=NSLOT*SLOTB, LDS_WS=2*NSLOT*SLOTB, LDS_OST=LDS_WS+NW*64*4, LDS_BYTES=LDS_OST+NW*4096;
constexpr float C2=0.125f*1.4426950408889634f;
__device__ __forceinline__ void glds16(const void*gsrc,unsigned lds_dst){unsigned keep;
  asm volatile("s_mov_b32 %0, m0\n\ts_mov_b32 m0, %2\n\ts_nop 0\n\tglobal_load_lds_dwordx4 %1, off\n\ts_mov_b32 m0, %0":"=&s"(keep):"v"(gsrc),"s"(lds_dst):"memory");}
__device__ __forceinline__ float max3f(float a,float b,float c){float r;asm("v_max3_f32 %0, %1, %2, %3":"=v"(r):"v"(a),"v"(b),"v"(c));return r;}
__device__ __forceinline__ float max2f(float a,float b){float r;asm("v_max_f32_e32 %0, %1, %2":"=v"(r):"v"(a),"v"(b));return r;}
__device__ __forceinline__ float fadd_s(float a,float b){float r;asm("v_add_f32_e32 %0, %1, %2":"=v"(r):"v"(a),"v"(b));return r;}
__device__ __forceinline__ float fsub_s(float a,float b){float r;asm("v_sub_f32_e32 %0, %1, %2":"=v"(r):"v"(a),"v"(b));return r;}
typedef float f32x2_t __attribute__((ext_vector_type(2))); typedef __bf16 bf16x2_t __attribute__((ext_vector_type(2)));
__device__ __forceinline__ unsigned cvtpk_s(float lo,float hi){f32x2_t v={lo,hi};bf16x2_t b=__builtin_convertvector(v,bf16x2_t);return __builtin_bit_cast(unsigned,b);}
#define WAIT_BAR(N) asm volatile("s_waitcnt vmcnt(" #N ") lgkmcnt(0)\n\ts_barrier":::"memory")

__device__ __forceinline__ void qkt(f32x16&p0,f32x16&p1,const char*Kslot,const bf16x8*qr,const f32x16&negm,int r32,int hi){
  const char*kb=Kslot+hi*1024+r32*16;
  #pragma unroll
  for(int d0=0;d0<4;++d0){
    const bf16x8 b0=*reinterpret_cast<const bf16x8*>(kb+d0*2048);
    const bf16x8 b1=*reinterpret_cast<const bf16x8*>(kb+d0*2048+512);
    if(d0==0){p0=__builtin_amdgcn_mfma_f32_32x32x16_bf16(b0,qr[0],negm,0,0,0);p1=__builtin_amdgcn_mfma_f32_32x32x16_bf16(b1,qr[0],negm,0,0,0);}
    else{p0=__builtin_amdgcn_mfma_f32_32x32x16_bf16(b0,qr[d0],p0,0,0,0);p1=__builtin_amdgcn_mfma_f32_32x32x16_bf16(b1,qr[d0],p1,0,0,0);}}
}
typedef __attribute__((address_space(3))) const char* lds_cptr;
typedef short v4i16_t __attribute__((ext_vector_type(4)));
__device__ __forceinline__ void kload8(bf16x8*kf,lds_cptr kp){
  kf[0]=*(const __attribute__((address_space(3))) bf16x8*)(kp);      kf[1]=*(const __attribute__((address_space(3))) bf16x8*)(kp+512);
  kf[2]=*(const __attribute__((address_space(3))) bf16x8*)(kp+2048); kf[3]=*(const __attribute__((address_space(3))) bf16x8*)(kp+2560);
  kf[4]=*(const __attribute__((address_space(3))) bf16x8*)(kp+4096); kf[5]=*(const __attribute__((address_space(3))) bf16x8*)(kp+4608);
  kf[6]=*(const __attribute__((address_space(3))) bf16x8*)(kp+6144); kf[7]=*(const __attribute__((address_space(3))) bf16x8*)(kp+6656);
}
__device__ __forceinline__ void kload2(bf16x8*kf,lds_cptr kp,int j){ kf[2*j]=*(const __attribute__((address_space(3))) bf16x8*)(kp+j*2048); kf[2*j+1]=*(const __attribute__((address_space(3))) bf16x8*)(kp+j*2048+512); }
__device__ __forceinline__ s16x4 vtr(lds_cptr p){ return __builtin_bit_cast(s16x4,__builtin_amdgcn_ds_read_tr16_b64_v4i16((__attribute__((address_space(3))) v4i16_t*)p)); }
__device__ __forceinline__ float rowmax(const f32x16&p0,const f32x16&p1){
  float a=max3f(p0[0],p0[1],p1[0]),b=max3f(p0[2],p0[3],p1[1]);a=max3f(a,p1[2],p1[3]);
  #pragma unroll
  for(int r=4;r<16;r+=4){a=max3f(a,p0[r],p0[r+1]);b=max3f(b,p0[r+2],p0[r+3]);a=max3f(a,p1[r],p1[r+1]);b=max3f(b,p1[r+2],p1[r+3]);}
  const float m=max2f(a,b);
  auto rr=__builtin_amdgcn_permlane32_swap(__float_as_uint(m),__float_as_uint(m),false,false);
  return max2f(__uint_as_float(rr[0]),__uint_as_float(rr[1]));
}
__device__ __forceinline__ void pv(f32x16*o,int vb,bf16x8 pa0,bf16x8 pa1,bf16x8 pa2,bf16x8 pa3){
  #pragma unroll
  for(int d0=0;d0<2;++d0){s16x4 lo[4],hi[4];
    #pragma unroll
    for(int ks=0;ks<4;++ks){
      asm volatile("ds_read_b64_tr_b16 %0,%1 offset:%c2":"=&v"(lo[ks]):"v"(vb),"i"(d0*4096+ks*1024):"memory");
      asm volatile("ds_read_b64_tr_b16 %0,%1 offset:%c2":"=&v"(hi[ks]):"v"(vb),"i"(d0*4096+ks*1024+512):"memory");}
    asm volatile("s_waitcnt lgkmcnt(0)":::"memory");SBAR();
    #define PK(k) (bf16x8){lo[k][0],lo[k][1],lo[k][2],lo[k][3],hi[k][0],hi[k][1],hi[k][2],hi[k][3]}
    o[d0]=__builtin_amdgcn_mfma_f32_32x32x16_bf16(pa0,PK(0),o[d0],0,0,0);
    o[d0]=__builtin_amdgcn_mfma_f32_32x32x16_bf16(pa1,PK(1),o[d0],0,0,0);
    o[d0]=__builtin_amdgcn_mfma_f32_32x32x16_bf16(pa2,PK(2),o[d0],0,0,0);
    o[d0]=__builtin_amdgcn_mfma_f32_32x32x16_bf16(pa3,PK(3),o[d0],0,0,0);
    #undef PK
  }
}

#ifndef ATTN_STORE16
#define ATTN_STORE16(p,v) (*(u32x4*)(p)=(v))
#endif
template<int THRL> __device__ __forceinline__ void attn_unit(int b,int h,int qb,const bf16*Q,const bf16*__restrict__ K,const bf16*__restrict__ V,bf16*O,const bf16*__restrict__ SG,const float*__restrict__ KM,char*shm,int wave_s){
  const int lane=mk_lane(),r32=lane&31,hi=lane>>5; const int wid=__builtin_amdgcn_readfirstlane(wave_s);
  const long rowbase=(long)b*SEQ; const int q0=qb*QB;
  const bf16*Qw=Q+(rowbase+q0+wid*QBLK)*DM+h*D;
  const bf16*Kh=K+rowbase*DM+h*D,*Vh=V+rowbase*DM+h*D;
  const unsigned lds0=(unsigned)(uintptr_t)shm;
  float*wsf=(float*)(shm+LDS_WS)+wid*64;
  const bf16*ksrc=Kh+(long)lane*DM+wid*8;
  const bf16*vsrc=Vh+(long)(16*(wid&3)+(lane>>2))*DM+(wid>>2)*32+(lane&3)*8;
  const unsigned kdst=lds0+LDS_K+wid*1024, vdst=lds0+LDS_V+wid*1024;
  #define DMA_K(t,slot) glds16(ksrc+(long)(t)*KVBLK*DM,(unsigned)__builtin_amdgcn_readfirstlane(kdst+(slot)))
  #define DMA_V(t,slot) glds16(vsrc+(long)(t)*KVBLK*DM,(unsigned)__builtin_amdgcn_readfirstlane(vdst+(slot)))
  const int vb0=(int)(lds0+LDS_V)+((lane>>4)&1)*32+(lane&3)*8+(4*hi+((lane&15)>>2))*64;
  const char*Kbase=shm+LDS_K; bf16x8 kf[8];
  const lds_cptr shm3=(lds_cptr)shm; const lds_cptr kp0=shm3+LDS_K+hi*1024+r32*16; const lds_cptr vp0=shm3+LDS_V+((lane>>4)&1)*32+(lane&3)*8+(4*hi+((lane&15)>>2))*64;
  const int NT=(q0+QB)/KVBLK;
  DMA_K(0,0);DMA_V(0,0);DMA_K(1,SLOTB);
  unsigned selbits=0u;
  if(qb>0){
    float qf[32];
    #pragma unroll
    for(int c=0;c<4;++c){ const u32x4 w=*reinterpret_cast<const u32x4*>(&Qw[(long)r32*DM+hi*32+c*8]);
      qf[c*8+0]=__uint_as_float(w.x<<16);qf[c*8+1]=__uint_as_float(w.x&0xffff0000u);qf[c*8+2]=__uint_as_float(w.y<<16);qf[c*8+3]=__uint_as_float(w.y&0xffff0000u);
      qf[c*8+4]=__uint_as_float(w.z<<16);qf[c*8+5]=__uint_as_float(w.z&0xffff0000u);qf[c*8+6]=__uint_as_float(w.w<<16);qf[c*8+7]=__uint_as_float(w.w&0xffff0000u); }
    const float*kmb=KM+((long)(b*NHEAD+h)*NQB)*D+hi*32;
    float g0=-3.0e38f,g1=-3.0e38f,g2=-3.0e38f; int s0=-1,s1=-1,s2=-1;
    for(int j=0;j<qb;++j){ const float*km=kmb+j*D; float a=0.f;
      #pragma unroll
      for(int c=0;c<8;++c){ const float4 kv=*reinterpret_cast<const float4*>(km+c*4); a+=qf[c*4]*kv.x; a+=qf[c*4+1]*kv.y; a+=qf[c*4+2]*kv.z; a+=qf[c*4+3]*kv.w; }
      const float gj=a+__shfl_xor(a,32);
      if(gj>g0){g2=g1;s2=s1;g1=g0;s1=s0;g0=gj;s0=j;} else if(gj>g1){g2=g1;s2=s1;g1=gj;s1=j;} else if(gj>g2){g2=gj;s2=j;} }
    if(s0>=0)selbits|=1u<<s0; if(s1>=0)selbits|=1u<<s1; if(s2>=0)selbits|=1u<<s2;
  }
  bf16x8 qr[4];
  #pragma unroll
  for(int d0=0;d0<4;++d0)qr[d0]=*reinterpret_cast<const bf16x8*>(&Qw[(long)r32*DM+d0*16+hi*8]);
  float mhat=0.f,l_reg=0.f;f32x16 o[2];o[0]=f32x16{};o[1]=f32x16{};f32x16 negm=f32x16{};asm volatile("":"+v"(negm));
  const int qrel=wid*QBLK+r32;
  #define SELM(P0,P1,t) do{ if(!((selbits>>((t)>>2))&1u)){ _Pragma("unroll") for(int r=0;r<16;++r){P0[r]=-INFINITY;P1[r]=-INFINITY;} } }while(0)
  #define CMASK(P0,P1,t) do{int jb_=(t)-(NT-4); if(jb_>=0)cmask(P0,P1,jb_,qrel,hi); else SELM(P0,P1,t);}while(0)
  bool resc=false;
  #define START(P0,P1) do{ const float rm=rowmax(P0,P1); resc=false; \
    { const float dl=__builtin_fmaxf(rm,-60.f); mhat=fadd_s(mhat,dl); \
      _Pragma("unroll") for(int r=0;r<16;++r){P0[r]=fsub_s(P0[r],dl);P1[r]=fsub_s(P1[r],dl);} \
      _Pragma("unroll") for(int r=0;r<16;++r)negm[r]=-mhat; asm volatile("":"+v"(negm)); } \
    _Pragma("unroll") for(int r=0;r<16;++r)P0[r]=__builtin_amdgcn_exp2f(P0[r]); }while(0)
  #define RESC() do{ if(resc){ asm volatile("s_waitcnt lgkmcnt(0)":::"memory"); \
      _Pragma("unroll") for(int d_=0;d_<2;++d_) _Pragma("unroll") for(int r=0;r<16;++r)o[d_][r]*=wsf[crow(r,hi)]; } }while(0)
  f32x16 pA0,pA1,pB0,pB1;
  int sl_prev=0,sl_cur=0,sl_next=SLOTB;
  #define ROT() do{sl_prev=sl_cur;sl_cur=sl_next;sl_next=(sl_next==(NSLOT-1)*SLOTB)?0:sl_next+SLOTB;}while(0)
  DMA_K(2,2*SLOTB);
  WAIT_BAR(3);
  qkt(pA0,pA1,Kbase,qr,negm,r32,hi);asm volatile("s_nop 15\n\ts_nop 7":"+v"(pA0),"+v"(pA1));CMASK(pA0,pA1,0);
  START(pA0,pA1);
  _Pragma("unroll") for(int r=0;r<16;++r)pA1[r]=__builtin_amdgcn_exp2f(pA1[r]);
  WAIT_BAR(0);
  DMA_K(3,0);DMA_V(1,SLOTB);
  ROT();
  kload8(kf,kp0+sl_cur);
  WAIT_BAR(2);
  s16x4 vlo[8],vhi[8]; u32x4 pw0,pw1,pw2,pw3;
  #define PKW(P,B) cvtpk_s(P[B],P[B+1])
  #define PAF(k) __builtin_bit_cast(bf16x8,pw##k)
  #define VFR(i) (bf16x8){vlo[i][0],vlo[i][1],vlo[i][2],vlo[i][3],vhi[i][0],vhi[i][1],vhi[i][2],vhi[i][3]}
  #define PIN(x) asm volatile("":"+v"(x))
  #define MX3(a,b,c) __builtin_fmaxf(__builtin_fmaxf((a),(b)),(c))
  #define GAPA(MF,A0,A1,A2,A3,W0,W1,PW) do{ MF; sacc+=A0; sacc+=A1; sacc+=A2; sacc+=A3; PIN(sacc); W0; W1; PIN(PW); SBAR(); }while(0)
  #define EX(v) __builtin_amdgcn_exp2f(v)
  #define GAPB(MF,X,B) do{ MF; X[B]=EX(X[B]); X[B+1]=EX(X[B+1]); X[B+2]=EX(X[B+2]); X[B+3]=EX(X[B+3]); PIN(X); SBAR(); }while(0)
  #define VRD(i) do{ vlo[i]=vtr(vp_+(((i)>>2)*4096+((i)&3)*1024)); vhi[i]=vtr(vp_+(((i)>>2)*4096+((i)&3)*1024+512)); }while(0)
  #define KRD(G,j) do{ if(G){ kload2(kf,kp0+sl_next,j); SBAR(); } }while(0)
  #define STEP(C0,C1,P0,P1,t,GK,GV,GL) do{ SBAR(); \
    const lds_cptr vp_=vp0+sl_prev; \
    VRD(0); SBAR(); float sacc=(P0[0]+P0[1]); \
    GAPA(C0=__builtin_amdgcn_mfma_f32_32x32x16_bf16(kf[0],qr[0],negm,0,0,0), P0[2],P0[3],P0[4],P0[5],     pw0[0]=PKW(P0,0), pw0[1]=PKW(P0,2), pw0); \
    VRD(4); SBAR(); GAPA(C1=__builtin_amdgcn_mfma_f32_32x32x16_bf16(kf[1],qr[0],negm,0,0,0), P0[6],P0[7],P0[8],P0[9],     pw0[2]=PKW(P0,4), pw0[3]=PKW(P0,6), pw0); \
    VRD(1); SBAR(); GAPA(C0=__builtin_amdgcn_mfma_f32_32x32x16_bf16(kf[2],qr[1],C0,0,0,0),   P0[10],P0[11],P0[12],P0[13], pw1[0]=PKW(P0,8), pw1[1]=PKW(P0,10), pw1); \
    VRD(5); SBAR(); GAPA(C1=__builtin_amdgcn_mfma_f32_32x32x16_bf16(kf[3],qr[1],C1,0,0,0),   P0[14],P0[15],P1[0],P1[1],   pw1[2]=PKW(P0,12),pw1[3]=PKW(P0,14), pw1); \
    VRD(2); SBAR(); GAPA(C0=__builtin_amdgcn_mfma_f32_32x32x16_bf16(kf[4],qr[2],C0,0,0,0),   P1[2],P1[3],P1[4],P1[5],     pw2[0]=PKW(P1,0), pw2[1]=PKW(P1,2), pw2); \
    VRD(6); SBAR(); GAPA(C1=__builtin_amdgcn_mfma_f32_32x32x16_bf16(kf[5],qr[2],C1,0,0,0),   P1[6],P1[7],P1[8],P1[9],     pw2[2]=PKW(P1,4), pw2[3]=PKW(P1,6), pw2); \
    VRD(3); SBAR(); GAPA(C0=__builtin_amdgcn_mfma_f32_32x32x16_bf16(kf[6],qr[3],C0,0,0,0),   P1[10],P1[11],P1[12],P1[13], pw3[0]=PKW(P1,8), pw3[1]=PKW(P1,10), pw3); \
    VRD(7); SBAR(); GAPA(C1=__builtin_amdgcn_mfma_f32_32x32x16_bf16(kf[7],qr[3],C1,0,0,0),   P1[14],P1[15],0.f,0.f,       pw3[2]=PKW(P1,12),pw3[3]=PKW(P1,14), pw3); \
    l_reg+=sacc; \
    if(GK){DMA_K((t)+3,sl_cur);} if(GV){DMA_V((t)+1,sl_next);} \
    CMASK(C0,C1,t); \
    { float a=MX3(C0[0],C0[1],C1[0]),b=MX3(C0[2],C0[3],C1[1]); a=MX3(a,C1[2],C1[3]); \
      _Pragma("unroll") for(int r=4;r<16;r+=4){a=MX3(a,C0[r],C0[r+1]);b=MX3(b,C0[r+2],C0[r+3]);a=MX3(a,C1[r],C1[r+1]);b=MX3(b,C1[r+2],C1[r+3]);} \
      float rm=__builtin_fmaxf(a,b); { auto rr=__builtin_amdgcn_permlane32_swap(__float_as_uint(rm),__float_as_uint(rm),false,false); rm=__builtin_fmaxf(__uint_as_float(rr[0]),__uint_as_float(rr[1])); } \
      resc=false; \
      if(__builtin_expect(__any(rm>(float)THRL),0)){ const float dl=__builtin_fmaxf(rm,0.f); mhat+=dl; \
        _Pragma("unroll") for(int r=0;r<16;++r){C0[r]-=dl;C1[r]-=dl;} \
        _Pragma("unroll") for(int r=0;r<16;++r)negm[r]=-mhat; asm volatile("":"+v"(negm)); \
        const float f=__builtin_amdgcn_exp2f(-dl); l_reg*=f; if(hi==0)wsf[r32]=f; resc=true; } } \
    SBAR(); \
    GAPB(o[0]=__builtin_amdgcn_mfma_f32_32x32x16_bf16(PAF(0),VFR(0),o[0],0,0,0), C0,0); \
    GAPB(o[1]=__builtin_amdgcn_mfma_f32_32x32x16_bf16(PAF(0),VFR(4),o[1],0,0,0), C0,4); \
    KRD(GL,0); GAPB(o[0]=__builtin_amdgcn_mfma_f32_32x32x16_bf16(PAF(1),VFR(1),o[0],0,0,0), C0,8); \
    KRD(GL,1); GAPB(o[1]=__builtin_amdgcn_mfma_f32_32x32x16_bf16(PAF(1),VFR(5),o[1],0,0,0), C0,12); \
    KRD(GL,2); GAPB(o[0]=__builtin_amdgcn_mfma_f32_32x32x16_bf16(PAF(2),VFR(2),o[0],0,0,0), C1,0); \
    KRD(GL,3); GAPB(o[1]=__builtin_amdgcn_mfma_f32_32x32x16_bf16(PAF(2),VFR(6),o[1],0,0,0), C1,4); \
    GAPB(o[0]=__builtin_amdgcn_mfma_f32_32x32x16_bf16(PAF(3),VFR(3),o[0],0,0,0), C1,8); \
    GAPB(o[1]=__builtin_amdgcn_mfma_f32_32x32x16_bf16(PAF(3),VFR(7),o[1],0,0,0), C1,12); \
    }while(0)
  int t=1;
  #undef CMASK
  #define CMASK(P0,P1,t) SELM(P0,P1,t)
  for(;t+5<NT;t+=2){
    STEP(pB0,pB1,pA0,pA1,t,true,true,true);     WAIT_BAR(2); RESC(); ROT();
    STEP(pA0,pA1,pB0,pB1,t+1,true,true,true);   WAIT_BAR(2); RESC(); ROT();
  }
  #undef CMASK
  #define CMASK(P0,P1,t) do{int jb_=(t)-(NT-4); if(jb_>=0)cmask(P0,P1,jb_,qrel,hi); else SELM(P0,P1,t);}while(0)
  #define ENDW(tt) do{ if((tt)+3<NT){WAIT_BAR(2);} else if((tt)+2<NT){WAIT_BAR(1);} else {WAIT_BAR(0);} }while(0)
  for(;t+1<NT;t+=2){
    STEP(pB0,pB1,pA0,pA1,t,(t+3<NT),(t+1<NT),(t+1<NT));       ENDW(t);   RESC(); ROT();
    STEP(pA0,pA1,pB0,pB1,t+1,(t+4<NT),(t+2<NT),(t+2<NT));     ENDW(t+1); RESC(); ROT();
  }
  STEP(pB0,pB1,pA0,pA1,NT-1,false,false,false); RESC();
  { float sacc=pB0[0]+pB0[1]; _Pragma("unroll") for(int r=2;r<16;++r)sacc+=pB0[r]; _Pragma("unroll") for(int r=0;r<16;++r)sacc+=pB1[r]; l_reg+=sacc;
    pw0=(u32x4){PKW(pB0,0),PKW(pB0,2),PKW(pB0,4),PKW(pB0,6)};pw1=(u32x4){PKW(pB0,8),PKW(pB0,10),PKW(pB0,12),PKW(pB0,14)};pw2=(u32x4){PKW(pB1,0),PKW(pB1,2),PKW(pB1,4),PKW(pB1,6)};pw3=(u32x4){PKW(pB1,8),PKW(pB1,10),PKW(pB1,12),PKW(pB1,14)};
    SBAR(); pv(o,vb0+sl_cur,PAF(0),PAF(1),PAF(2),PAF(3)); }
  #undef PKW
  #undef PAF
  #undef VFR
  #undef PIN
  #undef MX3
  #undef GAPA
  #undef GAPB
  #undef EX
  #undef VRD
  #undef KRD
  #undef STEP
  #undef ENDW
  {auto rr=__builtin_amdgcn_permlane32_swap(__float_as_uint(l_reg),__float_as_uint(l_reg),false,false);l_reg=__uint_as_float(rr[0])+__uint_as_float(rr[1]);}
  if(hi==0)wsf[32+r32]=l_reg;asm volatile("s_waitcnt lgkmcnt(0)":::"memory");
  float rli[16];
  #pragma unroll
  for(int r=0;r<16;++r)rli[r]=__builtin_amdgcn_rcpf(wsf[32+crow(r,hi)]);
  bf16*Ow=O+(rowbase+q0+wid*QBLK)*YP+YOFF+h*D; const bf16*Gw=SG+(rowbase+q0+wid*QBLK)*DM+h*D;
  { bf16*stg=(bf16*)(shm+LDS_OST)+wid*2048;
    #pragma unroll
    for(int r=0;r<16;++r){const int orow=crow(r,hi);
      #pragma unroll
      for(int d0=0;d0<2;++d0)stg[orow*64+d0*32+r32]=__float2bfloat16(o[d0][r]*rli[r]);}
    asm volatile("s_waitcnt lgkmcnt(0)":::"memory");
    int le=lane; asm volatile("":"+v"(le));
    #pragma unroll
    for(int i=0;i<4;++i){const int row=i*8+(le>>3),ch=le&7; const u32x4 v=*(const u32x4*)(stg+row*64+ch*8); const u32x4 g=*(const u32x4*)(Gw+(row*DM+ch*8)); u32x4 w;
      w.x=cvtpk_s(__uint_as_float(v.x<<16)*__uint_as_float(g.x<<16),__uint_as_float(v.x&0xffff0000u)*__uint_as_float(g.x&0xffff0000u));
      w.y=cvtpk_s(__uint_as_float(v.y<<16)*__uint_as_float(g.y<<16),__uint_as_float(v.y&0xffff0000u)*__uint_as_float(g.y&0xffff0000u));
      w.z=cvtpk_s(__uint_as_float(v.z<<16)*__uint_as_float(g.z<<16),__uint_as_float(v.z&0xffff0000u)*__uint_as_float(g.z&0xffff0000u));
      w.w=cvtpk_s(__uint_as_float(v.w<<16)*__uint_as_float(g.w<<16),__uint_as_float(v.w&0xffff0000u)*__uint_as_float(g.w&0xffff0000u));
      ATTN_STORE16(Ow+(row*YP+ch*8),w);} }
  asm volatile("s_waitcnt lgkmcnt(0)\n\ts_barrier":::"memory");
  #undef DMA_K
  #undef DMA_V
  #undef CMASK
  #undef SELM
  #undef START
  #undef RESC
  #undef ROT
}
constexpr int ATTN_LDS_BYTES=LDS_BYTES;
struct AttnTensors { const bf16* Q; const bf16* K; const bf16* V; bf16* O; const bf16* SG; const float* KM; };
struct AttnUnit { int bh; int qb; };
struct StaticOrder {
  int vcu;
  __device__ __forceinline__ explicit StaticOrder(int grid,int block):vcu((block%8)*(grid/8)+block/8){}
  __device__ __forceinline__ bool next(int i,AttnUnit&u)const{ if(i>=4)return false; const int s=vcu&3; u.bh=vcu>>2; u.qb=(i==0)?15-s:(i==1)?8+s:(i==2)?7-s:s; return true; }
  __device__ __forceinline__ void a_ready(const AttnUnit&)const{}
  __device__ __forceinline__ void done(const AttnUnit&)const{}
};
template<class Sched,int THRL=8> __device__ __forceinline__ void attn_phase(char*lds,const AttnTensors&T,const Sched&S,int wave_s){
  AttnUnit u;
  for(int i=0;S.next(i,u);++i){ S.a_ready(u); attn_unit<THRL>(u.bh/NHEAD,u.bh%NHEAD,u.qb,T.Q,T.K,T.V,T.O,T.SG,T.KM,lds,wave_s); S.done(u); }
}
#undef SBAR
#undef WAIT_BAR
}

#define LAS __attribute__((address_space(3)))
#define XB_TMO      128
#define XB_XCNT(j)  (256  + 64 * (j))
#define XB_XSUB(j)  (1280 + 64 * (j))
#define XB_XGEN(j)  (2304 + 64 * (j))
#define XB_TOP      3328
#define XB_TOPGEN   3392
#define XCD_BAR_WORDS 3456
#define XB_SPIN_CAP (1u << 18)

__device__ __forceinline__ unsigned xb_ld(unsigned* p)              { return __hip_atomic_load(p, __ATOMIC_RELAXED, __HIP_MEMORY_SCOPE_AGENT); }
__device__ __forceinline__ unsigned xb_add(unsigned* p, unsigned v) { return __hip_atomic_fetch_add(p, v, __ATOMIC_RELAXED, __HIP_MEMORY_SCOPE_AGENT); }
__device__ __forceinline__ unsigned xb_xcc_id() { return (unsigned)__builtin_amdgcn_s_getreg((3 << 11) | 20) & 0xFu; }
#define XB_SPIN(cond, bar) do { unsigned _sp = 0; while (cond) { __builtin_amdgcn_s_sleep(1); \
    if ((++_sp & 255u) == 0u) { if (xb_ld(&(bar)[XB_TMO])) break; if (_sp > XB_SPIN_CAP) { atomicAdd(&(bar)[XB_TMO], 1u); break; } } } } while (0)

struct XcdBarrier {
    unsigned* bar; unsigned x;
    volatile LAS unsigned* st;
};

__device__ __forceinline__ XcdBarrier xcd_barrier_post(unsigned* bar, volatile LAS unsigned* st) {
    XcdBarrier b; b.bar = bar; b.x = xb_xcc_id(); b.st = st;
    if (threadIdx.x == 0) (void)xb_add(&bar[XB_XCNT(b.x)], 1u);
    return b;
}
__device__ __forceinline__ void xcd_barrier_complete(unsigned* bar, unsigned x, unsigned& nloc, unsigned& nx) {
    const unsigned G = gridDim.x * gridDim.y * gridDim.z;
    unsigned sum, cnt, mine, sp = 0u;
    for (;;) {
        sum = 0u; cnt = 0u; mine = 0u;
#pragma unroll
        for (unsigned j = 0; j < 16; ++j) { const unsigned c = xb_ld(&bar[XB_XCNT(j)]); sum += c; cnt += (c > 0u) ? 1u : 0u; mine = (j == x) ? c : mine; }
        if (sum == G) break;
        __builtin_amdgcn_s_sleep(1);
        if ((++sp & 255u) == 0u) { if (xb_ld(&bar[XB_TMO])) break; if (sp > XB_SPIN_CAP) { atomicAdd(&bar[XB_TMO], 1u); break; } }
    }
    nloc = mine > 0u ? mine : 1u; nx = cnt > 0u ? cnt : 1u;
}

__device__ __forceinline__ void xcd_barrier(const XcdBarrier& b) {
    asm volatile("s_waitcnt vmcnt(0)" ::: "memory");
    __syncthreads();
    if (threadIdx.x == 0) {
        unsigned* bar = b.bar;
        __builtin_amdgcn_s_waitcnt(0);
        unsigned nloc = b.st[0], nx = b.st[1];
        if (nloc == 0u) { xcd_barrier_complete(bar, b.x, nloc, nx); b.st[0] = nloc; b.st[1] = nx; }
        const unsigned old = xb_add(&bar[XB_XSUB(b.x)], 1u);
        const unsigned gen = old / nloc;
        if (old + 1u == (gen + 1u) * nloc) {
            __builtin_amdgcn_fence(__ATOMIC_RELEASE, "agent");
            asm volatile("s_waitcnt vmcnt(0)" ::: "memory");
            const unsigned og = xb_add(&bar[XB_TOP], 1u);
            const unsigned tg = og / nx;
            if (og + 1u == (tg + 1u) * nx) xb_add(&bar[XB_TOPGEN], 1u);
            else XB_SPIN(xb_ld(&bar[XB_TOPGEN]) == tg, bar);
            __builtin_amdgcn_fence(__ATOMIC_ACQUIRE, "agent");
            xb_add(&bar[XB_XGEN(b.x)], 1u);
            asm volatile("s_waitcnt vmcnt(0)" ::: "memory");
        } else {
            XB_SPIN(xb_ld(&bar[XB_XGEN(b.x)]) == gen, bar);
            __builtin_amdgcn_fence(__ATOMIC_ACQUIRE, "agent");
            asm volatile("s_waitcnt vmcnt(0)" ::: "memory");
        }
    }
    __syncthreads();
}

constexpr int CW_BAR = 4096;
constexpr int LDSCTL_OFF = 131072;

struct Args { const void* in[15]; float* out; unsigned char* ws; int ph_lo, ph_hi; };
constexpr int NPH = 7;

__global__ void __launch_bounds__(512, 2) mk_fwd(Args args) {
    extern __shared__ __attribute__((aligned(16))) unsigned char lds[];
    Frame F;
    F.lds = lds; F.tid = threadIdx.x; F.lane = F.tid & 63; F.wave = __builtin_amdgcn_readfirstlane(F.tid >> 6);
    F.G = gridDim.x; { const int bx = blockIdx.x; F.vcu = (F.G % 8 == 0) ? (bx % 8) * (F.G / 8) + bx / 8 : bx; }
    F.x = (const float*)args.in[0]; F.c = (const float*)args.in[1]; F.pos = (const int*)args.in[2]; F.w_ada = (const float*)args.in[3]; F.b_ada = (const float*)args.in[4];
    F.g_norm = (const float*)args.in[5]; F.w_in = (const float*)args.in[6]; F.w_dw = (const float*)args.in[7]; F.b_dw = (const float*)args.in[8];
    F.g_ln = (const float*)args.in[9]; F.b_ln = (const float*)args.in[10]; F.w_pw = (const float*)args.in[11]; F.b_pw = (const float*)args.in[12];
    F.w_out = (const float*)args.in[13]; F.g_final = (const float*)args.in[14];
    F.out = args.out; F.ws = args.ws;
    const int lo = args.ph_lo, hi = args.ph_hi;
    for (int u = F.tid; u < (LDS_BYTES - LDSCTL_OFF) / 4; u += 512) ((LAS unsigned*)((LAS unsigned char*)lds + LDSCTL_OFF))[u] = 0u;
    __syncthreads();
    XcdBarrier bar = xcd_barrier_post((unsigned*)(F.ws + WS_CTL) + CW_BAR, (volatile LAS unsigned*)((LAS unsigned char*)lds + LDSCTL_OFF) + 8);
#define IN(k) (lo <= (k) && (k) < hi)
#define SEAM(k) do { if (IN(k) && IN((k) + 1)) xcd_barrier(bar); } while (0)
    PG8_LAS unsigned char* ldsl = (PG8_LAS unsigned char*)lds;
    if (IN(0)) { p0_mod(F); p0_rope(F); p0_weights(F); }
    SEAM(0);
    if (IN(1)) p1_h(F);
    SEAM(1);
    if (IN(2)) {
        pg8::Gemm g{(const bf16*)(F.ws + WS_H), (const bf16*)(F.ws + WS_WIN), T_, DIN, D_}; pg8::StaticOrder S; S.init(T_, DIN, F.G, (int)blockIdx.x);
        EpiProj E{(bf16*)(F.ws + WS_U), (bf16*)(F.ws + WS_SGC), (bf16*)(F.ws + WS_Q), (bf16*)(F.ws + WS_K), (bf16*)(F.ws + WS_V), (bf16*)(F.ws + WS_SGA), (const float*)(F.ws + WS_ROPE), (float*)(F.ws + WS_KMEAN)};
        pg8::gemm_phase<EpiProj, pg8::StaticOrder, true, true>(ldsl, g, S, E, F.wave);
    }
    SEAM(2);
    if (IN(3)) {
        p3_conv(F, ldsl);
        __syncthreads();
        const attn_body::AttnTensors AT{(const attn_body::bf16*)(F.ws + WS_Q), (const attn_body::bf16*)(F.ws + WS_K), (const attn_body::bf16*)(F.ws + WS_V), (attn_body::bf16*)(F.ws + WS_YCAT),
                                        (const attn_body::bf16*)(F.ws + WS_SGA), (const float*)(F.ws + WS_KMEAN)};
        const attn_body::StaticOrder S((int)F.G, (int)blockIdx.x);
        attn_body::attn_phase<attn_body::StaticOrder>((char*)lds, AT, S, F.wave);
    }
    SEAM(3);
    F.lane = mk_lane(); F.tid = F.wave * 64 + F.lane;
    if (IN(4)) {
        pg8::Gemm g{(const bf16*)(F.ws + WS_ALN), (const bf16*)(F.ws + WS_WPW), T_, DC, DC}; pg8::StaticOrder S; S.init(T_, DC, F.G, (int)blockIdx.x);
        EpiPw E{(bf16*)(F.ws + WS_YCAT), (const bf16*)(F.ws + WS_SGC), F.b_pw};
        pg8::gemm_phase<EpiPw, pg8::StaticOrder, true, true>(ldsl, g, S, E, F.wave);
    }
    SEAM(4);
    if (IN(5)) {
        pg8::Gemm g{(const bf16*)(F.ws + WS_YCAT), (const bf16*)(F.ws + WS_WOUT), T_, D_, D_}; pg8::StaticOrder S; S.init(T_, D_, F.G, (int)blockIdx.x);
        EpiOut E{F.out, F.x, (const float*)(F.ws + WS_MOD)};
        pg8::gemm_phase<EpiOut, pg8::StaticOrder, true, true>(ldsl, g, S, E, F.wave);
    }
    SEAM(5);
    if (IN(6)) p6_final(F);
#undef IN
#undef SEAM
}

extern "C" void kernel_launch(void* const* d_in, const int* in_sizes, int n_in, void* d_out, int out_size, void* d_ws, size_t ws_size, hipStream_t stream) {
    static int grid = 0;
    if (grid == 0) {
        if (n_in != 15 || out_size != T_ * D_ || ws_size < WS_END) { fprintf(stderr, "kernel_launch: unexpected problem (n_in %d out %d ws %zu)\n", n_in, out_size, ws_size); grid = -1; return; }
        int dev = 0, cus = 0, per_cu = 0;
        hipGetDevice(&dev); hipDeviceGetAttribute(&cus, hipDeviceAttributeMultiprocessorCount, dev);
        hipFuncSetAttribute((const void*)mk_fwd, hipFuncAttributeMaxDynamicSharedMemorySize, LDS_BYTES);
        hipOccupancyMaxActiveBlocksPerMultiprocessor(&per_cu, (const void*)mk_fwd, 512, LDS_BYTES);
        if (per_cu < 1) per_cu = 1;
        (void)hipGetLastError();
        grid = cus * per_cu;
    }
    if (grid < 0) return;
    hipMemsetAsync((char*)d_ws + WS_CTL, 0, CTL_ZERO, stream);
    Args a{};
    for (int i = 0; i < 15; ++i) a.in[i] = d_in[i];
    a.out = (float*)d_out; a.ws = (unsigned char*)d_ws;
    a.ph_lo = 0; a.ph_hi = NPH;
    void* kargs[] = {&a};
    hipError_t e = hipLaunchCooperativeKernel((const void*)mk_fwd, dim3(grid), dim3(512), kargs, LDS_BYTES, stream);
    if (e != hipSuccess) fprintf(stderr, "cooperative launch failed: %s (grid %d)\n", hipGetErrorString(e), grid);
}
```
